# Optimizing an MI355X kernel written in HIP

```python
import math
import jax
import jax.numpy as jnp
from jax import lax
import numpy as np

D_MODEL = 1024
BATCH = 8
SEQ = 4096
DEPTH = 4

GRID_W = 64
CTX_LEN = 256
N_MIXERS = 3
FFN_HIDDEN = -(-8 * D_MODEL // (3 * 256)) * 256
CONV_WIDTH = 3
MLA_HEADS = D_MODEL // 64
MLA_Q_LORA = 3 * D_MODEL // 4
MLA_KV_LORA = D_MODEL // 4
MLA_NOPE = 64
MLA_ROPE = 32
MLA_V = 64
DIFF_HEADS = 8
DIFF_HEAD_DIM = D_MODEL // (2 * DIFF_HEADS)
ROPE_THETA = 10000.0
NORM_EPS = 1e-6
Q_BLOCK = 128

kernel_name = 'hybrid_conv_mla_diffattn_dit_trunk'


def rms_norm(x, g):
    xf = x.astype(jnp.float32)
    y = xf * lax.rsqrt(jnp.mean(xf * xf, axis=-1, keepdims=True) + NORM_EPS)
    return (y * g.astype(jnp.float32)).astype(x.dtype)


def modulate(h, shift, scale):
    return h * (1.0 + scale) + shift


def swiglu(h, w_gate, w_up, w_down):
    return (jax.nn.silu(h @ w_gate) * (h @ w_up)) @ w_down


def axial_rope_tables(rows, rot_dim):
    axis_dim = rot_dim // 2
    inv_freq = ROPE_THETA ** (-jnp.arange(0, axis_dim, 2, dtype=jnp.float32) / axis_dim)
    row = jnp.repeat(jnp.arange(rows, dtype=jnp.float32), GRID_W)
    col = jnp.tile(jnp.arange(GRID_W, dtype=jnp.float32), rows)
    ang_r = row[:, None] * inv_freq
    ang_c = col[:, None] * inv_freq
    ang = jnp.concatenate([ang_r, ang_r, ang_c, ang_c], axis=-1)
    return jnp.cos(ang), jnp.sin(ang)


def apply_axial_rope(x, cos, sin):
    a = x.shape[-1] // 2
    h = a // 2
    xr, xc = x[..., :a], x[..., a:]
    rot = jnp.concatenate([-xr[..., h:], xr[..., :h], -xc[..., h:], xc[..., :h]], axis=-1)
    return x * cos.astype(x.dtype) + rot * sin.astype(x.dtype)


def sweep_query_blocks(block_fn, *qs):
    b, n = qs[0].shape[:2]
    if n % Q_BLOCK or n == Q_BLOCK:
        return block_fn(*qs)
    nb = n // Q_BLOCK
    blocks = tuple(jnp.swapaxes(a.reshape(b, nb, Q_BLOCK, *a.shape[2:]), 0, 1) for a in qs)
    out = lax.map(lambda blk: block_fn(*blk), blocks)
    out = jnp.swapaxes(out, 0, 1)
    return out.reshape(b, n, *out.shape[3:])


def short_conv_mixer(h, w_in, conv_k, conv_b, w_out):
    b_gate, c_gate, u = jnp.split(h @ w_in, 3, axis=-1)
    z = c_gate * u
    pad = CONV_WIDTH // 2
    y = lax.conv_general_dilated(z, conv_k[:, None, :], window_strides=(1,), padding=((pad, pad),),
                                 dimension_numbers=('NWC', 'WIO', 'NWC'), feature_group_count=D_MODEL)
    y = y + conv_b
    return (b_gate * y) @ w_out


def _mla_project(h, cos, sin, with_q, w_in, q_norm_g, w_q_up, kv_norm_g, w_kv_up,
                 qn_nope_g, qn_rope_g, kn_nope_g, kn_rope_g):
    b, n, _ = h.shape
    proj = h @ (w_in if with_q else w_in[:, MLA_Q_LORA:])
    if with_q:
        q_lat, proj = proj[..., :MLA_Q_LORA], proj[..., MLA_Q_LORA:]
    kv_lat, k_pe = proj[..., :MLA_KV_LORA], proj[..., MLA_KV_LORA:]
    kv = (rms_norm(kv_lat, kv_norm_g) @ w_kv_up).reshape(b, n, MLA_HEADS, MLA_NOPE + MLA_V)
    k_nope = rms_norm(kv[..., :MLA_NOPE], kn_nope_g)
    v = kv[..., MLA_NOPE:]
    k_pe = rms_norm(k_pe, kn_rope_g)
    if cos is not None:
        k_pe = apply_axial_rope(k_pe, cos, sin)
    if not with_q:
        return None, None, k_nope, k_pe, v
    q = (rms_norm(q_lat, q_norm_g) @ w_q_up).reshape(b, n, MLA_HEADS, MLA_NOPE + MLA_ROPE)
    q_nope = rms_norm(q[..., :MLA_NOPE], qn_nope_g)
    q_pe = rms_norm(q[..., MLA_NOPE:], qn_rope_g)
    if cos is not None:
        q_pe = apply_axial_rope(q_pe, cos[:, None, :], sin[:, None, :])
    return q_nope, q_pe, k_nope, k_pe, v


def _mla_block(k_nope, k_pe, v):
    scale = (MLA_NOPE + MLA_ROPE) ** -0.5

    def attend(q_nope, q_pe):
        s = (jnp.einsum('bqhd,bkhd->bhqk', q_nope, k_nope)
             + jnp.einsum('bqhr,bkr->bhqk', q_pe, k_pe))
        p = jax.nn.softmax(s.astype(jnp.float32) * scale, axis=-1).astype(v.dtype)
        return jnp.einsum('bhqk,bkhd->bqhd', p, v)
    return attend


def mla_mixer(a_ctx, a_lat, ctx_out, cos, sin, w_in, q_norm_g, w_q_up, kv_norm_g, w_kv_up,
              qn_nope_g, qn_rope_g, kn_nope_g, kn_rope_g, w_out):
    prm = (w_in, q_norm_g, w_q_up, kv_norm_g, w_kv_up, qn_nope_g, qn_rope_g, kn_nope_g, kn_rope_g)
    cq_n, cq_p, ck_n, ck_p, cv = _mla_project(a_ctx, None, None, ctx_out, *prm)
    lq_n, lq_p, lk_n, lk_p, lv = _mla_project(a_lat, cos, sin, True, *prm)
    b, n = a_lat.shape[:2]
    attend_lat = _mla_block(jnp.concatenate([ck_n, lk_n], axis=1),
                            jnp.concatenate([ck_p, lk_p], axis=1),
                            jnp.concatenate([cv, lv], axis=1))
    o_lat = sweep_query_blocks(attend_lat, lq_n, lq_p).reshape(b, n, MLA_HEADS * MLA_V) @ w_out
    o_ctx = None
    if ctx_out:
        o_ctx = sweep_query_blocks(_mla_block(ck_n, ck_p, cv), cq_n, cq_p)
        o_ctx = o_ctx.reshape(b, a_ctx.shape[1], MLA_HEADS * MLA_V) @ w_out
    return o_ctx, o_lat


def _diff_project(h, cos, sin, with_q, w_in, qn_g, kn_g):
    b, n, _ = h.shape
    proj = h @ (w_in if with_q else w_in[:, D_MODEL:])
    parts = jnp.split(proj, 3 if with_q else 2, axis=-1)
    k = rms_norm(parts[-2].reshape(b, n, DIFF_HEADS, 2, DIFF_HEAD_DIM), kn_g)
    v = parts[-1].reshape(b, n, DIFF_HEADS, 2 * DIFF_HEAD_DIM)
    if cos is not None:
        k = apply_axial_rope(k, cos[:, None, None, :], sin[:, None, None, :])
    if not with_q:
        return None, k, v
    q = rms_norm(parts[0].reshape(b, n, DIFF_HEADS, 2, DIFF_HEAD_DIM), qn_g)
    if cos is not None:
        q = apply_axial_rope(q, cos[:, None, None, :], sin[:, None, None, :])
    return q, k, v


def _diff_block(k, v, lam):
    scale = DIFF_HEAD_DIM ** -0.5
    k1, k2 = k[..., 0, :], k[..., 1, :]

    def attend(q):
        s1 = jnp.einsum('bqhd,bkhd->bhqk', q[..., 0, :], k1).astype(jnp.float32) * scale
        s2 = jnp.einsum('bqhd,bkhd->bhqk', q[..., 1, :], k2).astype(jnp.float32) * scale
        p = jax.nn.softmax(s1, axis=-1) - lam * jax.nn.softmax(s2, axis=-1)
        return jnp.einsum('bhqk,bkhe->bqhe', p.astype(v.dtype), v)
    return attend


def diff_mixer(a_ctx, a_lat, ctx_out, cos, sin, lam_init, w_in, qn_g, kn_g,
               lq1, lk1, lq2, lk2, sub_g, w_out):
    lam = (jnp.exp(jnp.sum(lq1.astype(jnp.float32) * lk1.astype(jnp.float32)))
           - jnp.exp(jnp.sum(lq2.astype(jnp.float32) * lk2.astype(jnp.float32))) + lam_init)
    cq, ck, cv = _diff_project(a_ctx, None, None, ctx_out, w_in, qn_g, kn_g)
    lq, lk, lv = _diff_project(a_lat, cos, sin, True, w_in, qn_g, kn_g)

    def finish(o):
        o = rms_norm(o, sub_g) * (1.0 - lam_init)
        return o.reshape(o.shape[0], o.shape[1], D_MODEL) @ w_out

    attend_lat = _diff_block(jnp.concatenate([ck, lk], axis=1), jnp.concatenate([cv, lv], axis=1), lam)
    o_lat = finish(sweep_query_blocks(attend_lat, lq))
    o_ctx = finish(sweep_query_blocks(_diff_block(ck, cv, lam), cq)) if ctx_out else None
    return o_ctx, o_lat


def setup_inputs(seed: int = 0) -> dict:
    key = jax.random.key(seed)
    ks = iter(jax.random.split(key, 40))

    def nrm(shape, scale):
        return jax.random.normal(next(ks), shape, jnp.float32) * scale

    def gain(shape):
        return 1.0 + 0.02 * jax.random.normal(next(ks), shape, jnp.float32)

    n_a, n_b, n_c = (len(range(k, DEPTH, N_MIXERS)) for k in range(N_MIXERS))
    d, f = D_MODEL, FFN_HIDDEN
    return {
        'x': nrm((BATCH, SEQ, d), 1.0),
        'c': nrm((BATCH, d), 1.0),
        'ctx': nrm((BATCH, CTX_LEN, d), 1.0),
        'c_ctx': nrm((d,), 1.0),
        'norm_mix_g': gain((DEPTH, d)),
        'norm_ffn_g': gain((DEPTH, d)),
        'mod_w': nrm((DEPTH, d, 6 * d), 0.5 * d ** -0.5),
        'mod_b': nrm((DEPTH, 6 * d), 0.02),
        'ffn_w_gate': nrm((DEPTH, d, f), d ** -0.5),
        'ffn_w_up': nrm((DEPTH, d, f), d ** -0.5),
        'ffn_w_down': nrm((DEPTH, f, d), f ** -0.5),
        'conv_w_in': nrm((n_a, d, 3 * d), d ** -0.5),
        'conv_k': nrm((n_a, CONV_WIDTH, d), CONV_WIDTH ** -0.5),
        'conv_b': nrm((n_a, d), 0.02),
        'conv_w_out': nrm((n_a, d, d), d ** -0.5),
        'mla_w_in': nrm((n_b, d, MLA_Q_LORA + MLA_KV_LORA + MLA_ROPE), d ** -0.5),
        'mla_q_norm_g': gain((n_b, MLA_Q_LORA)),
        'mla_w_q_up': nrm((n_b, MLA_Q_LORA, MLA_HEADS * (MLA_NOPE + MLA_ROPE)), MLA_Q_LORA ** -0.5),
        'mla_kv_norm_g': gain((n_b, MLA_KV_LORA)),
        'mla_w_kv_up': nrm((n_b, MLA_KV_LORA, MLA_HEADS * (MLA_NOPE + MLA_V)), MLA_KV_LORA ** -0.5),
        'mla_qn_nope_g': gain((n_b, MLA_NOPE)),
        'mla_qn_rope_g': gain((n_b, MLA_ROPE)),
        'mla_kn_nope_g': gain((n_b, MLA_NOPE)),
        'mla_kn_rope_g': gain((n_b, MLA_ROPE)),
        'mla_w_out': nrm((n_b, MLA_HEADS * MLA_V, d), (MLA_HEADS * MLA_V) ** -0.5),
        'diff_w_in': nrm((n_c, d, 3 * d), d ** -0.5),
        'diff_qn_g': gain((n_c, DIFF_HEAD_DIM)),
        'diff_kn_g': gain((n_c, DIFF_HEAD_DIM)),
        'diff_lq1': nrm((n_c, DIFF_HEAD_DIM), 0.1),
        'diff_lk1': nrm((n_c, DIFF_HEAD_DIM), 0.1),
        'diff_lq2': nrm((n_c, DIFF_HEAD_DIM), 0.1),
        'diff_lk2': nrm((n_c, DIFF_HEAD_DIM), 0.1),
        'diff_sub_g': gain((n_c, 2 * DIFF_HEAD_DIM)),
        'diff_w_out': nrm((n_c, d, d), d ** -0.5),
    }


def reference(x, c, ctx, c_ctx, norm_mix_g, norm_ffn_g, mod_w, mod_b, ffn_w_gate, ffn_w_up, ffn_w_down,
              conv_w_in, conv_k, conv_b, conv_w_out,
              mla_w_in, mla_q_norm_g, mla_w_q_up, mla_kv_norm_g, mla_w_kv_up,
              mla_qn_nope_g, mla_qn_rope_g, mla_kn_nope_g, mla_kn_rope_g, mla_w_out,
              diff_w_in, diff_qn_g, diff_kn_g, diff_lq1, diff_lk1, diff_lq2, diff_lk2, diff_sub_g, diff_w_out):
    n_lat = x.shape[1]
    rows = n_lat // GRID_W
    cos_mla, sin_mla = axial_rope_tables(rows, MLA_ROPE)
    cos_diff, sin_diff = axial_rope_tables(rows, DIFF_HEAD_DIM)
    silu_c = jax.nn.silu(c)
    silu_cctx = jax.nn.silu(c_ctx)
    h_lat, h_ctx = x, ctx
    for i in range(DEPTH):
        kind, slot = i % N_MIXERS, i // N_MIXERS
        last = i == DEPTH - 1
        sh1, sc1, g1, sh2, sc2, g2 = jnp.split((silu_c @ mod_w[i] + mod_b[i])[:, None, :], 6, axis=-1)
        a_lat = modulate(rms_norm(h_lat, norm_mix_g[i]), sh1, sc1)
        need_ctx_in = not (last and kind == 0)
        if need_ctx_in:
            csh1, csc1, cg1, csh2, csc2, cg2 = jnp.split(silu_cctx @ mod_w[i] + mod_b[i], 6, axis=-1)
            a_ctx = modulate(rms_norm(h_ctx, norm_mix_g[i]), csh1, csc1)
        if kind == 0:
            o_lat = short_conv_mixer(a_lat, conv_w_in[slot], conv_k[slot], conv_b[slot], conv_w_out[slot])
            o_ctx = None if last else short_conv_mixer(a_ctx, conv_w_in[slot], conv_k[slot], conv_b[slot],
                                                       conv_w_out[slot])
        elif kind == 1:
            o_ctx, o_lat = mla_mixer(a_ctx, a_lat, not last, cos_mla, sin_mla,
                                     mla_w_in[slot], mla_q_norm_g[slot], mla_w_q_up[slot],
                                     mla_kv_norm_g[slot], mla_w_kv_up[slot],
                                     mla_qn_nope_g[slot], mla_qn_rope_g[slot],
                                     mla_kn_nope_g[slot], mla_kn_rope_g[slot], mla_w_out[slot])
        else:
            lam_init = 0.8 - 0.6 * math.exp(-0.3 * i)
            o_ctx, o_lat = diff_mixer(a_ctx, a_lat, not last, cos_diff, sin_diff, lam_init,
                                      diff_w_in[slot], diff_qn_g[slot], diff_kn_g[slot],
                                      diff_lq1[slot], diff_lk1[slot], diff_lq2[slot], diff_lk2[slot],
                                      diff_sub_g[slot], diff_w_out[slot])
        h_lat = h_lat + g1 * o_lat
        h_lat = h_lat + g2 * swiglu(modulate(rms_norm(h_lat, norm_ffn_g[i]), sh2, sc2),
                                    ffn_w_gate[i], ffn_w_up[i], ffn_w_down[i])
        if not last:
            h_ctx = h_ctx + cg1 * o_ctx
            h_ctx = h_ctx + cg2 * swiglu(modulate(rms_norm(h_ctx, norm_ffn_g[i]), csh2, csc2),
                                         ffn_w_gate[i], ffn_w_up[i], ffn_w_down[i])
    return h_lat
```

```cpp
#ifndef ATT_REP
#define ATT_REP 1
#endif
#include <hip/hip_runtime.h>
#include <hip/hip_cooperative_groups.h>
#include <cstdio>
#include <cstdint>
namespace cg = cooperative_groups;
namespace pg8 {
#define PG8_LAS __attribute__((address_space(3)))
typedef unsigned short bf16_t;
typedef short bf16x8 __attribute__((ext_vector_type(8)));
typedef float f32x4 __attribute__((ext_vector_type(4)));
typedef unsigned u32x4 __attribute__((ext_vector_type(4)));
typedef _Float16 f16x8 __attribute__((ext_vector_type(8)));
typedef _Float16 f16x2 __attribute__((ext_vector_type(2)));
typedef float f32x2v __attribute__((ext_vector_type(2)));
constexpr int BM = 256, BK = 64, HALF = 128, HTB = HALF * BK * 2  , STAGE_BYTES = 8 * HTB, NXCD = 8, WGM = 4;

__host__ __device__ __forceinline__ int lds_byte(int r, int c) { const int st = (r >> 4) * 2 + (c >> 5), rr = r & 15, cc = c & 31, ob = rr * 64 + cc * 2; return st * 1024 + (ob ^ (((ob >> 9) & 1) << 5)); }
__host__ __device__ __forceinline__ void stage_rc(int b, int& R, int& C) { const int st = b / 1024, sb = b % 1024, swz = sb ^ (((sb >> 9) & 1) << 5); R = (st >> 1) * 16 + swz / 64; C = (st & 1) * 32 + (swz % 64) / 2; }
__host__ __device__ __forceinline__ int perm32(int rho) { const int n = rho >> 4, i = rho & 15; return 8 * (i >> 2) + 4 * n + (i & 3); }

struct Unit { int pm, pn; };
struct Gemm { const bf16_t* A; const bf16_t* Bt; int M, N, K, lda; };

struct StaticOrder {
    int nM, nN, nwg, G, c;
    __host__ __device__ void init(int M, int N, int G_, int c_) { nM = M / BM; nN = N / BM; nwg = nM * nN; G = G_; c = c_; }
    __host__ __device__ bool next(int i, Unit& u) const {
        const long L = (long)i * G + c; if (L >= nwg) return false;
        int wgid = (int)L; { const int q = nwg / NXCD, r = nwg % NXCD, xcd = wgid % NXCD, off = wgid / NXCD; wgid = (xcd < r ? xcd * (q + 1) : r * (q + 1) + (xcd - r) * q) + off; }
        const int nig = WGM * nN, gid = wgid / nig, fm = gid * WGM, gsz = (nM - fm) < WGM ? (nM - fm) : WGM;
        u.pm = fm + ((wgid % nig) % gsz); u.pn = (wgid % nig) / gsz; return true;
    }
    __device__ __forceinline__ void a_ready(const Unit&) const {}
    __device__ __forceinline__ void done(const Unit&) const {}
};

constexpr int ML_ = 32768, MT_ = 34816, DM_ = 1024;
constexpr float EPS_ = 1e-6f;
__device__ __forceinline__ unsigned cvt_pk_bf16(float lo, float hi) { const f32x2v v = {lo, hi}; return __builtin_bit_cast(unsigned, __builtin_convertvector(v, f16x2)); }
__device__ __forceinline__ u32x4 pack8(const f32x4 a, const f32x4 b) { u32x4 w; w.x = cvt_pk_bf16(a[0], a[1]); w.y = cvt_pk_bf16(a[2], a[3]); w.z = cvt_pk_bf16(b[0], b[1]); w.w = cvt_pk_bf16(b[2], b[3]); return w; }
__device__ __forceinline__ float sum4sq(const f32x4 a) { return (a[0] * a[0] + a[1] * a[1]) + (a[2] * a[2] + a[3] * a[3]); }
__device__ __forceinline__ float lanex(float v, int lane, int mask) { return __builtin_bit_cast(float, __builtin_amdgcn_ds_bpermute((lane ^ mask) << 2, __builtin_bit_cast(int, v))); }
__device__ __forceinline__ float red_fq(float s, int fr, int fq) { const int lane = fr | (fq << 4); s += lanex(s, lane, 16); s += lanex(s, lane, 32); return s; }
__device__ __forceinline__ f32x4 shfl4x(const f32x4 v, int fr, int fq, int mask) { const int lane = fr | (fq << 4); f32x4 r; r[0] = lanex(v[0], lane, mask); r[1] = lanex(v[1], lane, mask); r[2] = lanex(v[2], lane, mask); r[3] = lanex(v[3], lane, mask); return r; }
__device__ __forceinline__ float silu_fast(float x) { return x * __builtin_amdgcn_rcpf(1.0f + __builtin_amdgcn_exp2f(-1.4426950408889634f * x)); }

struct EpiResid {
    static constexpr bool PERM = false, AFTER_DRAIN = false;
    const float* base_lat; const float* base_ctx; float* out_lat; float* out_ctx; const float* gate;
    __device__ __forceinline__ void operator()(const f32x4 (&acc)[2][2][4][2], const Unit& u, int wr, int wc, int fr, int fq) const {
        const int rowt = u.pm * BM; const bool isctx = rowt >= ML_;
        const float* base = isctx ? base_ctx - (size_t)ML_ * DM_ : base_lat; float* out = isctx ? out_ctx - (size_t)ML_ * DM_ : out_lat;
        const int mi = isctx ? 8 : (rowt >> 12);
        const int col0 = u.pn * BM + wc * 32 + 4 * fq;
        const float* gp = gate + mi * 6144 + col0;
        f32x4 gv[2][2];
#pragma unroll
        for (int bj = 0; bj < 2; ++bj)
#pragma unroll
            for (int n = 0; n < 2; ++n) gv[bj][n] = *(const f32x4*)(gp + bj * HALF + n * 16);
#pragma unroll
        for (int ai = 0; ai < 2; ++ai)
#pragma unroll
            for (int m = 0; m < 4; ++m) { const size_t off = (size_t)(rowt + ai * HALF + wr * 64 + m * 16 + fr) * DM_ + col0;
#pragma unroll
                for (int bj = 0; bj < 2; ++bj)
#pragma unroll
                    for (int n = 0; n < 2; ++n) { const f32x4 bs = *(const f32x4*)(base + off + bj * HALF + n * 16); *(f32x4*)(out + off + bj * HALF + n * 16) = bs + gv[bj][n] * acc[ai][bj][m][n]; } }
    }
};
template <int MODE> struct EpiPair {
    static constexpr bool PERM = true, AFTER_DRAIN = false;
    bf16_t* O;
    __device__ __forceinline__ void operator()(const f32x4 (&acc)[2][2][4][2], const Unit& u, int wr, int wc, int fr, int fq) const {
        const int row0 = u.pm * BM + wr * 64 + fr;
        constexpr int ldo = MODE == 0 ? 2048 : 2816;
        if (MODE == 0 && u.pn < 4) {
#pragma unroll
            for (int ai = 0; ai < 2; ++ai)
#pragma unroll
                for (int m = 0; m < 4; ++m) { bf16_t* rowp = O + (size_t)(row0 + ai * HALF + m * 16) * ldo + u.pn * BM + wc * 32 + 8 * fq;
#pragma unroll
                    for (int bj = 0; bj < 2; ++bj) *(u32x4*)(rowp + bj * HALF) = pack8(acc[ai][bj][m][0], acc[ai][bj][m][1]); }
        } else {
            const int colo = (MODE == 0 ? 1024 + (u.pn - 4) * 128 : u.pn * 128) + wc * 32 + 8 * fq;
#pragma unroll
            for (int ai = 0; ai < 2; ++ai)
#pragma unroll
                for (int m = 0; m < 4; ++m) { bf16_t* rowp = O + (size_t)(row0 + ai * HALF + m * 16) * ldo + colo;
                    f32x4 r0, r1;
#pragma unroll
                    for (int e = 0; e < 4; ++e) {
                        if (MODE == 0) { r0[e] = acc[ai][0][m][0][e] * acc[ai][1][m][0][e]; r1[e] = acc[ai][0][m][1][e] * acc[ai][1][m][1][e]; }
                        else { r0[e] = silu_fast(acc[ai][0][m][0][e]) * acc[ai][1][m][0][e]; r1[e] = silu_fast(acc[ai][0][m][1][e]) * acc[ai][1][m][1][e]; } }
                    *(u32x4*)rowp = pack8(r0, r1); }
        }
    }
};
struct EpiMlaIn {
    static constexpr bool PERM = true, AFTER_DRAIN = false;
    bf16_t* QL; bf16_t* KVL; bf16_t* KPR; float* rowss;
    __device__ __forceinline__ void operator()(const f32x4 (&acc)[2][2][4][2], const Unit& u, int wr, int wc, int fr, int fq) const {
        const int row0 = u.pm * BM + wr * 64 + fr;
        if (u.pn == 4) {
            if (wc == 0) {
#pragma unroll
                for (int ai = 0; ai < 2; ++ai)
#pragma unroll
                    for (int m = 0; m < 4; ++m) *(u32x4*)(KPR + (size_t)(row0 + ai * HALF + m * 16) * 32 + 8 * fq) = pack8(acc[ai][0][m][0], acc[ai][0][m][1]);
            }
            return;
        }
        bf16_t* O = u.pn < 3 ? QL + u.pn * BM : KVL; const int ldo = u.pn < 3 ? 768 : 256;
#pragma unroll
        for (int ai = 0; ai < 2; ++ai)
#pragma unroll
            for (int m = 0; m < 4; ++m) { const int row = row0 + ai * HALF + m * 16; bf16_t* rowp = O + (size_t)row * ldo + wc * 32 + 8 * fq;
                float s = 0.f;
#pragma unroll
                for (int bj = 0; bj < 2; ++bj) { *(u32x4*)(rowp + bj * HALF) = pack8(acc[ai][bj][m][0], acc[ai][bj][m][1]); s += sum4sq(acc[ai][bj][m][0]) + sum4sq(acc[ai][bj][m][1]); }
                s = red_fq(s, fr, fq);
                if (fq == 0) atomicAdd(rowss + u.pn * MT_ + row, s); }
    }
};
struct EpiMlaQ {
    static constexpr bool PERM = true, AFTER_DRAIN = false;
    bf16_t* Q; const float* rowss; const float* g_nope; const float* g_rope; const float* tab; float scale;
    __device__ __forceinline__ void operator()(const f32x4 (&acc)[2][2][4][2], const Unit& u, int wr, int wc, int fr, int fq) const {
        const int row0 = u.pm * BM + wr * 64 + fr;
        if (u.pn < 4) {
            const int head = 4 * u.pn + wc;
            f32x4 g[2][2];
#pragma unroll
            for (int bj = 0; bj < 2; ++bj)
#pragma unroll
                for (int n = 0; n < 2; ++n) g[bj][n] = *(const f32x4*)(g_nope + 32 * bj + 8 * fq + 4 * n);
#pragma unroll
            for (int ai = 0; ai < 2; ++ai)
#pragma unroll
                for (int m = 0; m < 4; ++m) { const int row = row0 + ai * HALF + m * 16;
                    const float rs = rsqrtf((rowss[row] + rowss[MT_ + row] + rowss[2 * MT_ + row]) * (1.0f / 768.0f) + EPS_);
                    float ss = 0.f;
#pragma unroll
                    for (int bj = 0; bj < 2; ++bj) ss += sum4sq(acc[ai][bj][m][0]) + sum4sq(acc[ai][bj][m][1]);
                    ss = red_fq(ss, fr, fq);
                    const float inv = rs * rsqrtf(rs * rs * ss * (1.0f / 64.0f) + EPS_) * scale;
                    bf16_t* rowp = Q + (size_t)row * 1536 + head * 96 + 8 * fq;
#pragma unroll
                    for (int bj = 0; bj < 2; ++bj) *(u32x4*)(rowp + 32 * bj) = pack8(acc[ai][bj][m][0] * inv * g[bj][0], acc[ai][bj][m][1] * inv * g[bj][1]); }
        } else {
            f32x4 g[2];
#pragma unroll
            for (int n = 0; n < 2; ++n) g[n] = *(const f32x4*)(g_rope + 8 * fq + 4 * n);
            const bool isctx = u.pm * BM >= ML_;
#pragma unroll
            for (int ai = 0; ai < 2; ++ai)
#pragma unroll
                for (int m = 0; m < 4; ++m) { const int row = row0 + ai * HALF + m * 16;
                    const float rs = rsqrtf((rowss[row] + rowss[MT_ + row] + rowss[2 * MT_ + row]) * (1.0f / 768.0f) + EPS_);
                    const int t = row & 4095; const int pos = (fq >> 1) ? (t & 63) : (t >> 6);
                    f32x4 cs[2], sn[2];
#pragma unroll
                    for (int n = 0; n < 2; ++n) { cs[n] = *(const f32x4*)(tab + pos * 8 + 4 * n); sn[n] = *(const f32x4*)(tab + 512 + pos * 8 + 4 * n); }
#pragma unroll
                    for (int bj = 0; bj < 2; ++bj) { const int head = 8 * (u.pn - 4) + 4 * bj + wc;
                        float ss = red_fq(sum4sq(acc[ai][bj][m][0]) + sum4sq(acc[ai][bj][m][1]), fr, fq);
                        const float inv = rs * rsqrtf(rs * rs * ss * (1.0f / 32.0f) + EPS_);
                        f32x4 y[2];
#pragma unroll
                        for (int n = 0; n < 2; ++n) { y[n] = acc[ai][bj][m][n] * inv * g[n];
                            const f32x4 yp = shfl4x(y[n], fr, fq, 16);
                            if (!isctx) y[n] = (fq & 1) ? (y[n] * cs[n] + yp * sn[n]) : (y[n] * cs[n] - yp * sn[n]);
                            y[n] = y[n] * scale; }
                        *(u32x4*)(Q + (size_t)row * 1536 + head * 96 + 64 + 8 * fq) = pack8(y[0], y[1]); } }
        }
    }
};
struct EpiMlaKV {
    static constexpr bool PERM = true, AFTER_DRAIN = false;
    bf16_t* K; bf16_t* V; const float* rowss; const float* g_nope;
    __device__ __forceinline__ void operator()(const f32x4 (&acc)[2][2][4][2], const Unit& u, int wr, int wc, int fr, int fq) const {
        const int row0 = u.pm * BM + wr * 64 + fr; const bool isk = u.pn < 4; const int head = 4 * (u.pn & 3) + wc;
        float eps_l = EPS_; asm volatile("" : "+v"(eps_l));
        bf16_t* obase = (isk ? K : V) + head * 64 + 8 * fq;
#pragma unroll
        for (int ai = 0; ai < 2; ++ai)
#pragma unroll
            for (int m = 0; m < 4; ++m) { const int row = row0 + ai * HALF + m * 16;
                const float rs = rsqrtf(rowss[row] * (1.0f / 256.0f) + eps_l);
                float inv = rs;
                if (isk) { float ss = 0.f;
#pragma unroll
                    for (int bj = 0; bj < 2; ++bj) ss += sum4sq(acc[ai][bj][m][0]) + sum4sq(acc[ai][bj][m][1]);
                    ss = red_fq(ss, fr, fq);
                    inv = rs * rsqrtf(rs * rs * ss * (1.0f / 64.0f) + eps_l); }
                bf16_t* rowp = obase + (size_t)row * 1024;
#pragma unroll
                for (int bj = 0; bj < 2; ++bj) { f32x4 a = acc[ai][bj][m][0] * inv, b = acc[ai][bj][m][1] * inv;
                    if (isk) { a = a * *(const f32x4*)(g_nope + 32 * bj + 8 * fq); b = b * *(const f32x4*)(g_nope + 32 * bj + 8 * fq + 4); }
                    *(u32x4*)(rowp + 32 * bj) = pack8(a, b); } }
    }
};
struct EpiDiff {
    static constexpr bool PERM = true, AFTER_DRAIN = false;
    bf16_t* O; const float* gq; const float* gk; const float* tab; float scale;
    __device__ __forceinline__ void operator()(const f32x4 (&acc)[2][2][4][2], const Unit& u, int wr, int wc, int fr, int fq) const {
        const int row0 = u.pm * BM + wr * 64 + fr;
        if (u.pn >= 8) {
#pragma unroll
            for (int ai = 0; ai < 2; ++ai)
#pragma unroll
                for (int m = 0; m < 4; ++m) { bf16_t* rowp = O + (size_t)(row0 + ai * HALF + m * 16) * 3072 + 2048 + (u.pn - 8) * 256 + wc * 64 + 8 * fq;
#pragma unroll
                    for (int bj = 0; bj < 2; ++bj) *(u32x4*)(rowp + 32 * bj) = pack8(acc[ai][bj][m][0], acc[ai][bj][m][1]); }
            return;
        }
        const bool isq = u.pn < 4; const int unit = 4 * (u.pn & 3) + wc; const float* gp = isq ? gq : gk; const float osc = isq ? scale : 1.0f;
        float eps_l = EPS_; asm volatile("" : "+v"(eps_l));
        const bool isctx = u.pm * BM >= ML_;
        f32x4 g[2][2];
#pragma unroll
        for (int bj = 0; bj < 2; ++bj)
#pragma unroll
            for (int n = 0; n < 2; ++n) g[bj][n] = *(const f32x4*)(gp + 32 * bj + 8 * fq + 4 * n);
#pragma unroll
        for (int ai = 0; ai < 2; ++ai)
#pragma unroll
            for (int m = 0; m < 4; ++m) { const int row = row0 + ai * HALF + m * 16;
                float ss = 0.f;
#pragma unroll
                for (int bj = 0; bj < 2; ++bj) ss += sum4sq(acc[ai][bj][m][0]) + sum4sq(acc[ai][bj][m][1]);
                ss = red_fq(ss, fr, fq);
                const float inv = rsqrtf(ss * (1.0f / 64.0f) + eps_l);
                const int t = row & 4095;
                bf16_t* rowp = O + (size_t)row * 3072 + (isq ? 0 : 1024) + unit * 64 + 8 * fq;
#pragma unroll
                for (int bj = 0; bj < 2; ++bj) { const int pos = bj ? (t & 63) : (t >> 6);
                    f32x4 y[2];
#pragma unroll
                    for (int n = 0; n < 2; ++n) { y[n] = acc[ai][bj][m][n] * inv * g[bj][n];
                        const f32x4 yp = shfl4x(y[n], fr, fq, 32);
                        if (!isctx) { const f32x4 cs = *(const f32x4*)(tab + pos * 16 + 8 * (fq & 1) + 4 * n), sn = *(const f32x4*)(tab + 1024 + pos * 16 + 8 * (fq & 1) + 4 * n);
                            y[n] = (fq >> 1) ? (y[n] * cs + yp * sn) : (y[n] * cs - yp * sn); }
                        y[n] = y[n] * osc; }
                    *(u32x4*)(rowp + 32 * bj) = pack8(y[0], y[1]); } }
    }
};
struct EpiStore {
    static constexpr bool PERM = true, AFTER_DRAIN = false;
    bf16_t* O; int ldo;
    __device__ __forceinline__ void operator()(const f32x4 (&acc)[2][2][4][2], const Unit& u, int wr, int wc, int fr, int fq) const {
        const int row0 = u.pm * BM + wr * 64 + fr;
#pragma unroll
        for (int ai = 0; ai < 2; ++ai)
#pragma unroll
            for (int m = 0; m < 4; ++m) { bf16_t* rowp = O + (size_t)(row0 + ai * HALF + m * 16) * ldo + u.pn * BM + wc * 32 + 8 * fq;
#pragma unroll
                for (int bj = 0; bj < 2; ++bj) *(u32x4*)(rowp + bj * HALF) = pack8(acc[ai][bj][m][0], acc[ai][bj][m][1]); }
    }
};

template <class Epi, class Sched, bool ALIGN_EPI = false, bool SP2 = false>
__device__ __forceinline__ void gemm_phase(PG8_LAS unsigned char* lds, const Gemm g, const Sched& S, const Epi& E) {
    int tid_o = threadIdx.x; asm volatile("" : "+v"(tid_o));
    const int tid = tid_o, wid = __builtin_amdgcn_readfirstlane(tid >> 6), lane = tid & 63, wr = wid >> 2, wc = wid & 3, fr = lane & 15, fq = lane >> 4;
    const int K = g.K, nt = K / BK;
    unsigned voffA[2], voffB[2];
#pragma unroll
    for (int i = 0; i < 2; ++i) { int R, C; stage_rc(tid * 16 + i * 8192, R, C); const int Rb = Epi::PERM ? ((R & ~31) + perm32(R & 31)) : R;
        voffA[i] = (unsigned)(R * g.lda + C) * 2u; voffB[i] = (unsigned)(Rb * K + C) * 2u; }
    const size_t kstep = (size_t)(BK * 2);
    const size_t hstep = (size_t)HALF * K * 2; const size_t hstepA = (size_t)HALF * g.lda * 2; const size_t tstepA = 2 * hstepA;
    const size_t tstep = 2 * hstep;
    const unsigned ldsw = (unsigned)wid * 1024u;
    const int aoff = lds_byte(wr * 64 + fr, fq * 8), boff = lds_byte(wc * 32 + fr, fq * 8);
#define PG8_SA(b, h) (((b) * 2 + (h)) * HTB)
#define PG8_SB(b, h) ((4 + (b) * 2 + (h)) * HTB)
#define PG8_STAGE(bufoff, gbase, voff) do { _Pragma("unroll") for (int _i = 0; _i < 2; ++_i) \
        __builtin_amdgcn_global_load_lds((const unsigned*)((const char*)(gbase) + (voff)[_i]), (PG8_LAS unsigned*)(lds + (bufoff) + ldsw + _i * 8192), 16, 0, 0); } while (0)
#define PG8_LDA(dst, b, h) do { _Pragma("unroll") for (int m = 0; m < 4; ++m) _Pragma("unroll") for (int k = 0; k < 2; ++k) dst[m][k] = *(const PG8_LAS bf16x8*)(lds + PG8_SA(b, h) + aoff + m * 2048 + k * 1024); } while (0)
#define PG8_LDB(dst, b, h) do { _Pragma("unroll") for (int n = 0; n < 2; ++n) _Pragma("unroll") for (int k = 0; k < 2; ++k) dst[n][k] = *(const PG8_LAS bf16x8*)(lds + PG8_SB(b, h) + boff + n * 2048 + k * 1024); } while (0)
#define PG8_MMA(ai, bj, At, Bt) do { __builtin_amdgcn_s_setprio(1); _Pragma("unroll") for (int m = 0; m < 4; ++m) _Pragma("unroll") for (int n = 0; n < 2; ++n) _Pragma("unroll") for (int k = 0; k < 2; ++k) \
        acc[ai][bj][m][n] = __builtin_amdgcn_mfma_f32_16x16x32_f16(__builtin_bit_cast(f16x8, Bt[n][k]), __builtin_bit_cast(f16x8, At[m][k]), acc[ai][bj][m][n], 0, 0, 0); __builtin_amdgcn_s_setprio(0); } while (0)
#define PG8_WAIT_V(n) asm volatile("s_waitcnt vmcnt(" #n ")" ::: "memory")
#define PG8_WAIT_L(n) asm volatile("s_waitcnt lgkmcnt(" #n ")" ::: "memory")
#define PG8_BAR __builtin_amdgcn_s_barrier()
#define PG8_SCHED __builtin_amdgcn_sched_barrier(0)
    Unit cur, nxt; int ui = 0;
    if (!S.next(0, cur)) return;
    f32x4 acc[2][2][4][2];
#pragma unroll
    for (int a = 0; a < 2; ++a)
#pragma unroll
        for (int b = 0; b < 2; ++b)
#pragma unroll
            for (int m = 0; m < 4; ++m)
#pragma unroll
                for (int n = 0; n < 2; ++n) acc[a][b][m][n] = (f32x4){0.f, 0.f, 0.f, 0.f};
    bf16x8 At[4][2], B0[2][2], B1[2][2];
    const char* cA = (const char*)g.A + (size_t)cur.pm * tstepA; const char* cB = (const char*)g.Bt + (size_t)cur.pn * tstep;
    S.a_ready(cur);
    if constexpr (SP2) {
        PG8_STAGE(PG8_SB(0, 0), cB, voffB); PG8_STAGE(PG8_SB(0, 1), cB + hstep, voffB); PG8_STAGE(PG8_SA(0, 0), cA, voffA); PG8_STAGE(PG8_SA(0, 1), cA + hstepA, voffA);
        if (wr == 1) PG8_BAR;
        PG8_WAIT_V(2); PG8_BAR;
        PG8_STAGE(PG8_SB(1, 0), cB + kstep, voffB); PG8_STAGE(PG8_SA(1, 0), cA + kstep, voffA); PG8_STAGE(PG8_SB(1, 1), cB + hstep + kstep, voffB);
        PG8_WAIT_V(6); PG8_BAR;
    } else {
        PG8_STAGE(PG8_SB(0, 0), cB, voffB); PG8_STAGE(PG8_SA(0, 0), cA, voffA); PG8_STAGE(PG8_SB(0, 1), cB + hstep, voffB); PG8_STAGE(PG8_SA(0, 1), cA + hstepA, voffA);
        if (wr == 1) PG8_BAR;
        PG8_WAIT_V(4); PG8_BAR;
        PG8_STAGE(PG8_SB(1, 0), cB + kstep, voffB); PG8_STAGE(PG8_SA(1, 0), cA + kstep, voffA); PG8_STAGE(PG8_SB(1, 1), cB + hstep + kstep, voffB);
        PG8_WAIT_V(6); PG8_BAR;
    }
    for (;;) {
        const bool has_next = S.next(ui + 1, nxt);
        const char* nA = has_next ? (const char*)g.A + (size_t)nxt.pm * tstepA : cA; const char* nB = has_next ? (const char*)g.Bt + (size_t)nxt.pn * tstep : cB;
        for (int t = 0; t < nt; t += 2) {
            const bool last = (t == nt - 2);
            const char* a1 = cA + (size_t)(t + 1) * kstep;
            const char* a2 = last ? nA : cA + (size_t)(t + 2) * kstep; const char* b2 = last ? nB : cB + (size_t)(t + 2) * kstep;
            const char* a3 = a2 + kstep; const char* b3 = b2 + kstep;
            if (last && has_next) S.a_ready(nxt);
            if constexpr (SP2) {
            PG8_LDB(B0, 0, 0); PG8_LDB(B1, 0, 1); PG8_SCHED; PG8_LDA(At, 0, 0); PG8_STAGE(PG8_SA(1, 1), a1 + hstepA, voffA);
            PG8_WAIT_V(8); PG8_WAIT_L(0); PG8_BAR; PG8_MMA(0, 0, At, B0); PG8_MMA(0, 1, At, B1); PG8_BAR; PG8_SCHED;
            PG8_LDA(At, 0, 1); PG8_STAGE(PG8_SB(0, 0), b2, voffB); PG8_STAGE(PG8_SB(0, 1), b2 + hstep, voffB); PG8_STAGE(PG8_SA(0, 0), a2, voffA);
            PG8_WAIT_V(8); PG8_WAIT_L(0); PG8_BAR; PG8_MMA(1, 0, At, B0); PG8_MMA(1, 1, At, B1); PG8_BAR; PG8_SCHED;
            PG8_LDB(B0, 1, 0); PG8_LDB(B1, 1, 1); PG8_SCHED; PG8_LDA(At, 1, 0); PG8_STAGE(PG8_SA(0, 1), a2 + hstepA, voffA);
            PG8_WAIT_V(8); PG8_WAIT_L(0); PG8_BAR; PG8_MMA(0, 0, At, B0); PG8_MMA(0, 1, At, B1); PG8_BAR; PG8_SCHED;
            PG8_LDA(At, 1, 1); PG8_STAGE(PG8_SB(1, 0), b3, voffB); PG8_STAGE(PG8_SB(1, 1), b3 + hstep, voffB); PG8_STAGE(PG8_SA(1, 0), a3, voffA);
            PG8_WAIT_V(8); PG8_WAIT_L(0); PG8_BAR; PG8_MMA(1, 0, At, B0); PG8_MMA(1, 1, At, B1); PG8_BAR; PG8_SCHED;
            } else {
            PG8_LDB(B0, 0, 0); PG8_SCHED; PG8_LDA(At, 0, 0); PG8_STAGE(PG8_SA(1, 1), a1 + hstepA, voffA);
            PG8_WAIT_L(8); PG8_BAR; PG8_WAIT_L(0); PG8_MMA(0, 0, At, B0); PG8_BAR; PG8_SCHED;
            PG8_LDB(B1, 0, 1); PG8_STAGE(PG8_SB(0, 0), b2, voffB);
            PG8_BAR; PG8_WAIT_L(0); PG8_MMA(0, 1, At, B1); PG8_BAR;
            PG8_LDA(At, 0, 1); PG8_STAGE(PG8_SA(0, 0), a2, voffA);
            PG8_BAR; PG8_WAIT_L(0); PG8_MMA(1, 0, At, B0); PG8_BAR; PG8_SCHED;
            PG8_STAGE(PG8_SB(0, 1), b2 + hstep, voffB);
            PG8_WAIT_V(6); PG8_BAR; PG8_MMA(1, 1, At, B1); PG8_BAR;
            PG8_LDB(B0, 1, 0); PG8_SCHED; PG8_LDA(At, 1, 0); PG8_STAGE(PG8_SA(0, 1), a2 + hstepA, voffA);
            PG8_WAIT_L(8); PG8_BAR; PG8_WAIT_L(0); PG8_MMA(0, 0, At, B0); PG8_BAR; PG8_SCHED;
            PG8_LDB(B1, 1, 1); PG8_STAGE(PG8_SB(1, 0), b3, voffB);
            PG8_BAR; PG8_WAIT_L(0); PG8_MMA(0, 1, At, B1); PG8_BAR;
            PG8_LDA(At, 1, 1); PG8_STAGE(PG8_SA(1, 0), a3, voffA);
            PG8_BAR; PG8_WAIT_L(0); PG8_MMA(1, 0, At, B0); PG8_BAR; PG8_SCHED;
            PG8_STAGE(PG8_SB(1, 1), b3 + hstep, voffB);
            PG8_WAIT_V(6); PG8_BAR; PG8_MMA(1, 1, At, B1); PG8_BAR;
            }
        }
        if constexpr (ALIGN_EPI) { if (wr == 0) PG8_BAR; }
        if constexpr (!Epi::AFTER_DRAIN) { int t2 = threadIdx.x; asm volatile("" : "+v"(t2)); const int fr2 = t2 & 15, fq2 = (t2 >> 4) & 3; E(acc, cur, wr, wc, fr2, fq2); S.done(cur); }
        if (!has_next) break;
#pragma unroll
        for (int a = 0; a < 2; ++a)
#pragma unroll
            for (int b = 0; b < 2; ++b)
#pragma unroll
                for (int m = 0; m < 4; ++m)
#pragma unroll
                    for (int n = 0; n < 2; ++n) acc[a][b][m][n] = (f32x4){0.f, 0.f, 0.f, 0.f};
        cur = nxt; cA = nA; cB = nB; ++ui;
        if constexpr (ALIGN_EPI) { if (wr == 1) PG8_BAR; }
    }
    PG8_WAIT_V(0);
    if constexpr (!ALIGN_EPI) { if (wr == 0) PG8_BAR; }
    PG8_BAR;
    if constexpr (Epi::AFTER_DRAIN) { E.fused(acc, cur, wr, wc, fr, fq, lds, wid, lane); S.done(cur); }
#undef PG8_SA
#undef PG8_SB
#undef PG8_STAGE
#undef PG8_LDA
#undef PG8_LDB
#undef PG8_MMA
#undef PG8_WAIT_V
#undef PG8_WAIT_L
#undef PG8_BAR
#undef PG8_SCHED
}
}
#define LAS __attribute__((address_space(3)))
typedef unsigned short bf16;
typedef unsigned v4u __attribute__((ext_vector_type(4)));
typedef unsigned v2u __attribute__((ext_vector_type(2)));
typedef float f32x4 __attribute__((ext_vector_type(4)));
typedef float f32x16 __attribute__((ext_vector_type(16)));
typedef short bf16x8 __attribute__((ext_vector_type(8)));
constexpr int D = 1024, NBATCH = 8, SEQ = 4096, CTXL = 256, FF = 2816;
constexpr int ML = NBATCH * SEQ, MC = NBATCH * CTXL, MT = ML + MC;
constexpr float EPS = 1e-6f;
constexpr float LOG2E = 1.4426950408889634f;
constexpr size_t MiB = 1u << 20;
constexpr size_t WS_ROWSS = 0;
constexpr size_t WS_TAB = 1 * MiB;
constexpr size_t WS_MOD = 2 * MiB;
constexpr size_t WS_HCTX = 4 * MiB;
constexpr size_t WS_W = 12 * MiB;
constexpr size_t W_IN = 0, W_B = 6 * MiB, W_C = 9 * MiB, W_OUT = 10 * MiB, W_GU = 12 * MiB, W_DN = 23 * MiB;
constexpr size_t WS_XN = 42 * MiB;
constexpr size_t WS_BIG = 110 * MiB;
constexpr size_t WS_KV = 314 * MiB;
constexpr size_t WS_KPE = 450 * MiB;
constexpr size_t WS_END = 454 * MiB;
constexpr size_t BIG_KVL = 52 * MiB, BIG_KPR = 70 * MiB;
constexpr size_t BIG_Q = 86 * MiB;
constexpr int LDS_BYTES = 147456;
#define XB_TMO      128
#define XB_XCNT(j)  (256  + 64 * (j))
#define XB_XSUB(j)  (1280 + 64 * (j))
#define XB_XGEN(j)  (2304 + 64 * (j))
#define XB_TOP      3328
#define XB_TOPGEN   3392
#define XCD_BAR_WORDS 3456
#define XB_SPIN_CAP (1u << 18)

__device__ __forceinline__ unsigned xb_ld(unsigned* p)              { return __hip_atomic_load(p, __ATOMIC_RELAXED, __HIP_MEMORY_SCOPE_AGENT); }
__device__ __forceinline__ unsigned xb_add(unsigned* p, unsigned v) { return __hip_atomic_fetch_add(p, v, __ATOMIC_RELAXED, __HIP_MEMORY_SCOPE_AGENT); }
__device__ __forceinline__ unsigned xb_xcc_id() { return (unsigned)__builtin_amdgcn_s_getreg((3 << 11) | 20) & 0xFu; }
#define XB_SPIN(cond, bar) do { unsigned _sp = 0; while (cond) { __builtin_amdgcn_s_sleep(1); \
    if ((++_sp & 255u) == 0u) { if (xb_ld(&(bar)[XB_TMO])) break; if (_sp > XB_SPIN_CAP) { atomicAdd(&(bar)[XB_TMO], 1u); break; } } } } while (0)

struct XcdBarrier {
    unsigned* bar; unsigned x;
    volatile LAS unsigned* st;
};

__device__ __forceinline__ XcdBarrier xcd_barrier_post(unsigned* bar, volatile LAS unsigned* st) {
    XcdBarrier b; b.bar = bar; b.x = xb_xcc_id(); b.st = st;
    if (threadIdx.x == 0) (void)xb_add(&bar[XB_XCNT(b.x)], 1u);
    return b;
}
__device__ __forceinline__ void xcd_barrier_complete(unsigned* bar, unsigned x, unsigned& nloc, unsigned& nx) {
    const unsigned G = gridDim.x * gridDim.y * gridDim.z;
    unsigned sum, cnt, mine, sp = 0u;
    for (;;) {
        sum = 0u; cnt = 0u; mine = 0u;
#pragma unroll
        for (unsigned j = 0; j < 16; ++j) { const unsigned c = xb_ld(&bar[XB_XCNT(j)]); sum += c; cnt += (c > 0u) ? 1u : 0u; mine = (j == x) ? c : mine; }
        if (sum == G) break;
        __builtin_amdgcn_s_sleep(1);
        if ((++sp & 255u) == 0u) { if (xb_ld(&bar[XB_TMO])) break; if (sp > XB_SPIN_CAP) { atomicAdd(&bar[XB_TMO], 1u); break; } }
    }
    nloc = mine > 0u ? mine : 1u; nx = cnt > 0u ? cnt : 1u;
}

__device__ __forceinline__ void xcd_barrier(const XcdBarrier& b) {
    asm volatile("s_waitcnt vmcnt(0)" ::: "memory");
    __syncthreads();
    if (threadIdx.x == 0) {
        unsigned* bar = b.bar;
        __builtin_amdgcn_s_waitcnt(0);
        unsigned nloc = b.st[0], nx = b.st[1];
        if (nloc == 0u) { xcd_barrier_complete(bar, b.x, nloc, nx); b.st[0] = nloc; b.st[1] = nx; }
        const unsigned old = xb_add(&bar[XB_XSUB(b.x)], 1u);
        const unsigned gen = old / nloc;
        if (old + 1u == (gen + 1u) * nloc) {
            __builtin_amdgcn_fence(__ATOMIC_RELEASE, "agent");
            asm volatile("s_waitcnt vmcnt(0)" ::: "memory");
            const unsigned og = xb_add(&bar[XB_TOP], 1u);
            const unsigned tg = og / nx;
            if (og + 1u == (tg + 1u) * nx) xb_add(&bar[XB_TOPGEN], 1u);
            else XB_SPIN(xb_ld(&bar[XB_TOPGEN]) == tg, bar);
            __builtin_amdgcn_fence(__ATOMIC_ACQUIRE, "agent");
            xb_add(&bar[XB_XGEN(b.x)], 1u);
            asm volatile("s_waitcnt vmcnt(0)" ::: "memory");
        } else {
            XB_SPIN(xb_ld(&bar[XB_XGEN(b.x)]) == gen, bar);
            __builtin_amdgcn_fence(__ATOMIC_ACQUIRE, "agent");
            asm volatile("s_waitcnt vmcnt(0)" ::: "memory");
        }
    }
    __syncthreads();
}

constexpr size_t WS_BAR = 3u << 20;
constexpr int BARGEN_OFF = 131072 + 512;
#define GRID_SYNC() xcd_barrier(xbar)
#define PHASE_IDS int t_o_ = threadIdx.x; asm volatile("" : "+v"(t_o_)); const int tid = t_o_, lane = tid & 63, wave = __builtin_amdgcn_readfirstlane(tid >> 6); const int gw = vcu * 8 + wave, gtid = bx * 512 + tid; (void)gw; (void)gtid; (void)lane; (void)wave;

struct Args { const float* in[34]; float* out; unsigned char* ws; };

__device__ __forceinline__ float wave_sum(float v) {
#pragma unroll
    for (int o = 1; o < 64; o <<= 1) v += __shfl_xor(v, o);
    return v;
}
__device__ __forceinline__ unsigned pk2(float lo, float hi) { return pg8::cvt_pk_bf16(lo, hi); }
__device__ __forceinline__ float bflo(unsigned w) { return (float)__builtin_bit_cast(pg8::f16x2, w)[0]; }
__device__ __forceinline__ float bfhi(unsigned w) { return (float)__builtin_bit_cast(pg8::f16x2, w)[1]; }


#ifdef DBG
#define DBG_OFF (WS_TAB + 65536)
#define DBG_SNAP (WS_TAB + 131072)
__device__ __forceinline__ void dbg_flag(unsigned char* ws, int bit) { atomicOr((unsigned*)(ws + DBG_OFF), 1u << bit); }
__device__ __forceinline__ bool dbg_bad(float got, float ref) { return !(fabsf(got - ref) <= 0.02f * fabsf(ref) + 0.02f); }
__device__ __forceinline__ unsigned hsh(unsigned x) { x ^= x >> 16; x *= 0x7feb352dU; x ^= x >> 15; x *= 0x846ca68bU; x ^= x >> 16; return x; }
__device__ __forceinline__ float h2f(const bf16* p) { return (float)*(const _Float16*)p; }
__device__ __forceinline__ float silu_x(float v) { return v / (1.0f + expf(-v)); }
#endif
enum { WK_IDENT = 0, WK_CONV_IN, WK_GU, WK_MLA_IN, WK_MLA_QUP, WK_MLA_KVUP, WK_PAIR64 };
__device__ __forceinline__ void conv_item(const float* W, int ldn, int K, int lcol, const float* gain, bf16* WT, int prow0, int k0, LAS float* scr, int lane) {
    if (lcol < 0) {
        const int c = lane & 7;
#pragma unroll
        for (int j = 0; j < 4; ++j) { const int n = (lane >> 3) + 8 * j; *(v4u*)(WT + (size_t)(prow0 + n) * K + k0 + 8 * c) = (v4u){0u, 0u, 0u, 0u}; }
        return;
    }
#pragma unroll 32
    for (int i = 0; i < 32; ++i) { const int kk = 2 * i + (lane >> 5); float v = W[(size_t)(k0 + kk) * ldn + lcol + (lane & 31)]; if (gain) v *= gain[k0 + kk]; scr[kk * 33 + (lane & 31)] = v; }
    asm volatile("s_waitcnt lgkmcnt(0)" ::: "memory");
    const int c = lane & 7;
#pragma unroll
    for (int j = 0; j < 4; ++j) { const int n = (lane >> 3) + 8 * j; const LAS float* s = scr + (8 * c) * 33 + n;
        v4u o; o.x = pk2(s[0 * 33], s[1 * 33]); o.y = pk2(s[2 * 33], s[3 * 33]); o.z = pk2(s[4 * 33], s[5 * 33]); o.w = pk2(s[6 * 33], s[7 * 33]);
        *(v4u*)(WT + (size_t)(prow0 + n) * K + k0 + 8 * c) = o; }
    asm volatile("s_waitcnt lgkmcnt(0)" ::: "memory");
}
__device__ __forceinline__ void conv_matrix_item(int kind, const float* s0, const float* s1, int ldn, int K, int Nphys, const float* gain, bf16* WT, int r, LAS float* scr, int lane) {
    const int ngr = Nphys / 32, kb = r / ngr, G = r % ngr; const int pn = G >> 3, bj = (G >> 2) & 1, wc = G & 3;
    const float* src = s0; int lcol = 32 * G;
    switch (kind) {
        case WK_CONV_IN: if (pn >= 4) lcol = (bj ? 2048 : 1024) + 128 * (pn - 4) + 32 * wc; break;
        case WK_GU: src = bj ? s1 : s0; lcol = 128 * pn + 32 * wc; break;
        case WK_MLA_IN: if (G >= 33) lcol = -1; break;
        case WK_MLA_QUP: lcol = pn < 4 ? (4 * pn + wc) * 96 + 32 * bj : (8 * (pn - 4) + 4 * bj + wc) * 96 + 64; break;
        case WK_MLA_KVUP: lcol = pn < 4 ? (4 * pn + wc) * 128 + 32 * bj : (4 * (pn - 4) + wc) * 128 + 64 + 32 * bj; break;
        case WK_PAIR64: lcol = 256 * pn + 64 * wc + 32 * bj; break;
        default: break;
    }
    conv_item(src, ldn, K, lcol, gain, WT, 32 * G, 64 * kb, scr, lane);
}
#define CONV_MAT(kind, s0, s1, ldn, K, Nphys, gain, dst) { const int ni_ = ((K) / 64) * ((Nphys) / 32); if (r < ni_) { conv_matrix_item(kind, s0, s1, ldn, K, Nphys, gain, dst, r, scr, lane); continue; } r -= ni_; }

template <int DQK, int DV, bool SPLIT> struct AttnP {
    const bf16* Q; int ldq;
    const bf16* K; int ldk;
    const bf16* Kpe;
    const bf16* V; int ldv;
    bf16* O;
    float lam, fin;
    const float* subg;
};
template <int DQK, int DV, bool SPLIT>
__device__ __forceinline__ void attn_unit(LAS unsigned char* lds, const AttnP<DQK, DV, SPLIT>& P, int b, int h, int qrow0, int ntiles_in) {
    constexpr int KW = SPLIT ? 128 : DQK;
    constexpr int KSTR = KW * 2 + 16, VSTR = 144;
    constexpr int KT = 64 * KSTR, VT = DV * VSTR, BUF = KT + VT;
    constexpr int NQ = DQK / 16, NDV = DV / 32;
    constexpr int NKC = SPLIT ? 2 : 1, NVC = DV / 64;
    int tid_o = threadIdx.x; asm volatile("" : "+v"(tid_o));
    const int tid = tid_o, lane = tid & 63, w = __builtin_amdgcn_readfirstlane(tid >> 6), l32 = lane & 31, hh = lane >> 5;
    const int stream = SPLIT ? (w >> 2) : 0;
    const int qrow = qrow0 + 32 * (SPLIT ? (w & 3) : w) + l32;
    int ntiles = ntiles_in; asm volatile("" : "+s"(ntiles));
    const int ctx0 = ML + b * CTXL, lat0 = b * SEQ;
    bf16x8 qf[NQ];
    { const bf16* qp = P.Q + (size_t)qrow * P.ldq + (SPLIT ? h * 128 + 64 * stream : h * DQK) + 8 * hh;
#pragma unroll
      for (int s = 0; s < NQ; ++s) qf[s] = *(const bf16x8*)(qp + 16 * s); }
    f32x16 o[NDV];
#pragma unroll
    for (int i = 0; i < NDV; ++i)
#pragma unroll
        for (int r = 0; r < 16; ++r) o[i][r] = 0.f;
    f32x16 negm;
    if constexpr (!SPLIT) {
#pragma unroll
    for (int r = 0; r < 16; ++r) negm[r] = -2.0f;
    } else {
#pragma unroll
    for (int r = 0; r < 16; ++r) negm[r] = 0.f;
    asm volatile("" : "+v"(negm));
    }
    float mrun = 0.f, lrun = 0.f;
    v4u kreg[2][NKC]; v4u kpreg[2]; v2u va[2][NVC], vb[2][NVC];
    const int vpr = tid & 31, vc4 = tid >> 5;
    const int vkey = ((2 * vpr) & ~12) | (((2 * vpr) >> 2) & 1) << 3 | (((2 * vpr) >> 3) & 1) << 2;
#define ATT_ROW0(t) (64 * (t) + (((t) < 4) ? ctx0 : lat0 - 256))
#define ATT_LOADK(t, S_) do { const int kr0_ = ATT_ROW0(t); \
        if (SPLIT) { _Pragma("unroll") for (int i_ = 0; i_ < NKC; ++i_) { const int idx_ = tid + 512 * i_; kreg[S_][i_] = *(const v4u*)(P.K + (size_t)(kr0_ + (idx_ >> 4)) * P.ldk + h * 128 + (idx_ & 15) * 8); } } \
        else { kreg[S_][0] = *(const v4u*)(P.K + (size_t)(kr0_ + (tid >> 3)) * P.ldk + h * 64 + (tid & 7) * 8); kpreg[S_] = *(const v4u*)(P.Kpe + (size_t)(kr0_ + ((tid & 255) >> 2)) * 32 + (tid & 3) * 8); } } while (0)
#define ATT_LOADV(t, S_) do { const int kr0_ = ATT_ROW0(t); \
        _Pragma("unroll") for (int i_ = 0; i_ < NVC; ++i_) { const bf16* vp_ = P.V + (size_t)(kr0_ + vkey) * P.ldv + h * DV + 4 * (vc4 + 16 * i_); va[S_][i_] = *(const v2u*)vp_; vb[S_][i_] = *(const v2u*)(vp_ + P.ldv); } } while (0)
#define ATT_STOREK(buf, S_) do { LAS unsigned char* kb_ = lds + (buf) * KT; \
        if (SPLIT) { _Pragma("unroll") for (int i_ = 0; i_ < NKC; ++i_) { const int idx_ = tid + 512 * i_; *(LAS v4u*)(kb_ + (idx_ >> 4) * KSTR + (idx_ & 15) * 16) = kreg[S_][i_]; } } \
        else { *(LAS v4u*)(kb_ + (tid >> 3) * KSTR + (tid & 7) * 16) = kreg[S_][0]; *(LAS v4u*)(kb_ + ((tid & 255) >> 2) * KSTR + 128 + (tid & 3) * 16) = kpreg[S_]; } } while (0)
#define ATT_STOREV(buf, S_) do { LAS unsigned char* vb_ = lds + 2 * KT + (buf) * VT; \
        _Pragma("unroll") for (int i_ = 0; i_ < NVC; ++i_) { LAS unsigned char* d_ = vb_ + (4 * (vc4 + 16 * i_)) * VSTR + vpr * 4; \
            *(LAS unsigned*)(d_) = (va[S_][i_].x & 0xffffu) | (vb[S_][i_].x << 16); *(LAS unsigned*)(d_ + VSTR) = (va[S_][i_].x >> 16) | (vb[S_][i_].x & 0xffff0000u); \
            *(LAS unsigned*)(d_ + 2 * VSTR) = (va[S_][i_].y & 0xffffu) | (vb[S_][i_].y << 16); *(LAS unsigned*)(d_ + 3 * VSTR) = (va[S_][i_].y >> 16) | (vb[S_][i_].y & 0xffff0000u); } } while (0)
#define ATT_QK(dst, buf) do { const LAS unsigned char* kb_ = lds + (buf) * KT; bf16x8 kf_[2][NQ]; \
        _Pragma("unroll") for (int kk = 0; kk < 2; ++kk) { const LAS unsigned char* kp = kb_ + (32 * kk + l32) * KSTR + (SPLIT ? 128 * stream : 0) + 16 * hh; \
            _Pragma("unroll") for (int q = 0; q < NQ; ++q) kf_[kk][q] = *(const LAS bf16x8*)(kp + 32 * q); } \
        __builtin_amdgcn_sched_barrier(0);     \
        _Pragma("unroll") for (int kk = 0; kk < 2; ++kk) dst[kk] = __builtin_amdgcn_mfma_f32_32x32x16_f16(__builtin_bit_cast(pg8::f16x8, kf_[kk][0]), __builtin_bit_cast(pg8::f16x8, qf[0]), negm, 0, 0, 0); \
        _Pragma("unroll") for (int q = 1; q < NQ; ++q) { _Pragma("unroll") for (int kk = 0; kk < 2; ++kk) \
            dst[kk] = __builtin_amdgcn_mfma_f32_32x32x16_f16(__builtin_bit_cast(pg8::f16x8, kf_[kk][q]), __builtin_bit_cast(pg8::f16x8, qf[q]), dst[kk], 0, 0, 0); } \
        __builtin_amdgcn_sched_barrier(0); } while (0)
    constexpr float THR = 6.0f;
    f32x16 s[2];
    ATT_LOADK(0, 0); ATT_LOADV(0, 0); ATT_LOADK(1, 1); ATT_LOADV(1, 1);
    ATT_STOREK(0, 0); ATT_STOREV(0, 0);
    asm volatile("s_waitcnt lgkmcnt(0)\n\ts_barrier" ::: "memory");
    if (w >= 4) asm volatile("s_barrier" ::: "memory");
    for (int t0 = 0; t0 < ntiles; t0 += 2) {
#pragma unroll
      for (int u2 = 0; u2 < 2; ++u2) {
        const int t = t0 + u2;
        { const int tl_ = (t + 2 < ntiles) ? t + 2 : ntiles - 1; ATT_LOADK(tl_, u2); ATT_LOADV(tl_, u2); }
        ATT_QK(s, u2);
        if constexpr (SPLIT) {
        float mxa = __builtin_fmaxf(__builtin_fmaxf(s[0][0], s[0][1]), s[1][0]), mxb = __builtin_fmaxf(__builtin_fmaxf(s[0][2], s[0][3]), s[1][1]); mxa = __builtin_fmaxf(__builtin_fmaxf(mxa, s[1][2]), s[1][3]);
#pragma unroll
        for (int r = 4; r < 16; r += 4) { mxa = __builtin_fmaxf(__builtin_fmaxf(mxa, s[0][r]), s[0][r + 1]); mxb = __builtin_fmaxf(__builtin_fmaxf(mxb, s[0][r + 2]), s[0][r + 3]);
            mxa = __builtin_fmaxf(__builtin_fmaxf(mxa, s[1][r]), s[1][r + 1]); mxb = __builtin_fmaxf(__builtin_fmaxf(mxb, s[1][r + 2]), s[1][r + 3]); }
        float mx = __builtin_fmaxf(mxa, mxb);
        mx = fmaxf(mx, pg8::lanex(mx, lane, 32));
        if (t == 0 || __any(mx > THR)) {
            const float delta = (t == 0) ? mx : fmaxf(mx, 0.f); const float alpha = (t == 0) ? 0.f : __builtin_amdgcn_exp2f(-delta); mrun += delta; lrun *= alpha;
#pragma unroll
            for (int i = 0; i < NDV; ++i)
#pragma unroll
                for (int r = 0; r < 16; ++r) o[i][r] *= alpha;
#pragma unroll
            for (int kk = 0; kk < 2; ++kk)
#pragma unroll
                for (int r = 0; r < 16; ++r) s[kk][r] -= delta;
#pragma unroll
            for (int r = 0; r < 16; ++r) negm[r] = -mrun;
            asm volatile("" : "+v"(negm));
        }
        }
        ATT_STOREK((u2 ^ 1), (u2 ^ 1));
        asm volatile("s_waitcnt lgkmcnt(0)\n\ts_barrier" ::: "memory");
        float ps = 0.f, ps2 = 0.f;
#pragma unroll
        for (int kk = 0; kk < 2; ++kk)
#pragma unroll
            for (int r = 0; r < 16; r += 2) { s[kk][r] = __builtin_amdgcn_exp2f(s[kk][r]); s[kk][r + 1] = __builtin_amdgcn_exp2f(s[kk][r + 1]); ps += s[kk][r]; ps2 += s[kk][r + 1]; }
        lrun += ps + ps2;
        bf16x8 pf[2][2];
#pragma unroll
        for (int kk = 0; kk < 2; ++kk)
#pragma unroll
            for (int ss = 0; ss < 2; ++ss) { v4u wv; wv.x = pg8::cvt_pk_bf16(s[kk][8 * ss + 0], s[kk][8 * ss + 1]); wv.y = pg8::cvt_pk_bf16(s[kk][8 * ss + 2], s[kk][8 * ss + 3]);
                wv.z = pg8::cvt_pk_bf16(s[kk][8 * ss + 4], s[kk][8 * ss + 5]); wv.w = pg8::cvt_pk_bf16(s[kk][8 * ss + 6], s[kk][8 * ss + 7]); pf[kk][ss] = __builtin_bit_cast(bf16x8, wv); }
        { const LAS unsigned char* vbp = lds + 2 * KT + u2 * VT;
#pragma unroll
          for (int i = 0; i < NDV; i += 2) {
            bf16x8 vf[2][4];
#pragma unroll
            for (int j = 0; j < 2; ++j) { const LAS unsigned char* vp = vbp + (32 * (i + j) + l32) * VSTR + 16 * hh;
#pragma unroll
                for (int c = 0; c < 4; ++c) vf[j][c] = *(const LAS bf16x8*)(vp + 32 * c); }
            __builtin_amdgcn_sched_barrier(0);
#pragma unroll
            for (int c = 0; c < 4; ++c)
#pragma unroll
                for (int j = 0; j < 2; ++j) o[i + j] = __builtin_amdgcn_mfma_f32_32x32x16_f16(__builtin_bit_cast(pg8::f16x8, vf[j][c]), __builtin_bit_cast(pg8::f16x8, pf[c >> 1][c & 1]), o[i + j], 0, 0, 0);
            __builtin_amdgcn_sched_barrier(0);
          } }
        ATT_STOREV((u2 ^ 1), (u2 ^ 1));
        asm volatile("s_waitcnt lgkmcnt(0)\n\ts_barrier" ::: "memory");
      }
    }
    if (w < 4) asm volatile("s_barrier" ::: "memory");
#undef ATT_ROW0
#undef ATT_LOADK
#undef ATT_LOADV
#undef ATT_STOREK
#undef ATT_STOREV
#undef ATT_QK
    const float ltot = lrun + pg8::lanex(lrun, lane, 32);
    const float linv = 1.0f / ltot;
    if (!SPLIT) {
        bf16* op = P.O + (size_t)qrow * 1024 + h * DV + 4 * hh;
#pragma unroll
        for (int i = 0; i < NDV; ++i)
#pragma unroll
            for (int g = 0; g < 4; ++g) { v2u wv; wv.x = pg8::cvt_pk_bf16(o[i][4 * g] * linv, o[i][4 * g + 1] * linv); wv.y = pg8::cvt_pk_bf16(o[i][4 * g + 2] * linv, o[i][4 * g + 3] * linv);
                *(v2u*)(op + 32 * i + 8 * g) = wv; }
    } else {
        LAS f32x4* X = (LAS f32x4*)lds;
        if (w >= 4) {
#pragma unroll
            for (int i = 0; i < NDV; ++i)
#pragma unroll
                for (int g = 0; g < 4; ++g) X[(((w & 3) * 16 + i * 4 + g) * 64) + lane] = (f32x4){o[i][4 * g] * linv, o[i][4 * g + 1] * linv, o[i][4 * g + 2] * linv, o[i][4 * g + 3] * linv};
        }
        __syncthreads();
        if (w < 4) {
            float ss = 0.f;
#pragma unroll
            for (int i = 0; i < NDV; ++i)
#pragma unroll
                for (int g = 0; g < 4; ++g) { const f32x4 x2 = X[((w * 16 + i * 4 + g) * 64) + lane];
#pragma unroll
                    for (int e = 0; e < 4; ++e) { const float c = o[i][4 * g + e] * linv - P.lam * x2[e]; o[i][4 * g + e] = c; ss += c * c; } }
            ss += pg8::lanex(ss, lane, 32);
            const float rn = rsqrtf(ss * (1.0f / 128.0f) + EPS) * P.fin;
            bf16* op = P.O + (size_t)qrow * 1024 + h * DV + 4 * hh;
#pragma unroll
            for (int i = 0; i < NDV; ++i)
#pragma unroll
                for (int g = 0; g < 4; ++g) { const f32x4 gg = *(const f32x4*)(P.subg + 32 * i + 8 * g + 4 * hh);
                    v2u wv; wv.x = pg8::cvt_pk_bf16(o[i][4 * g] * rn * gg[0], o[i][4 * g + 1] * rn * gg[1]); wv.y = pg8::cvt_pk_bf16(o[i][4 * g + 2] * rn * gg[2], o[i][4 * g + 3] * rn * gg[3]);
                    *(v2u*)(op + 32 * i + 8 * g) = wv; }
        }
        __syncthreads();
    }
}

constexpr int PTAB_OFF = 131072 + 1024;
enum { I_X = 0, I_C, I_CTX, I_CCTX, I_NMG, I_NFG, I_MODW, I_MODB, I_FWG, I_FWU, I_FWD, I_CWIN, I_CK, I_CB, I_CWOUT, I_MWIN, I_MQNG, I_MWQUP, I_MKVNG, I_MWKVUP,
       I_MQNN, I_MQNR, I_MKNN, I_MKNR, I_MWOUT, I_DWIN, I_DQNG, I_DKNG, I_DLQ1, I_DLK1, I_DLQ2, I_DLK2, I_DSUBG, I_DWOUT, I_OUT, I_WS };
typedef __attribute__((address_space(4))) const unsigned long long* kptr_t;
__device__ __forceinline__ unsigned long long ptab_get(LAS unsigned char* lds, int i) {
    (void)lds; kptr_t ka = (kptr_t)__builtin_amdgcn_kernarg_segment_ptr(); asm volatile("" : "+s"(ka)); return ka[i];
}
#define GASP __attribute__((address_space(1)))
#define PF(i) ((const float*)(GASP const float*)ptab_get(lds, (i)))
#define PWS() ((unsigned char*)(GASP unsigned char*)ptab_get(lds, I_WS))
#define POUT() ((float*)(GASP float*)ptab_get(lds, I_OUT))

#ifndef KNOCK
#define KNOCK 0
#endif
#define GEMM_PHASE(ID_, EpiT, Aptr, lda_, Bptr, Mrows, Ncols, Kdim, ...) do { if constexpr (!((KNOCK >> (ID_)) & 1)) { pg8::Gemm g_{(const pg8::bf16_t*)(Aptr), (const pg8::bf16_t*)(Bptr), (Mrows), (Ncols), (Kdim), (lda_)}; pg8::StaticOrder S_; S_.init((Mrows), (Ncols), G, ((ID_) == 3 ? (bx + 192) % G : bx)); \
        EpiT E_{__VA_ARGS__}; pg8::gemm_phase<EpiT, pg8::StaticOrder, true, true>(lds, g_, S_, E_); } } while (0)
#define WSP(T, off) ((T*)(PWS() + (off)))
#define NORM_ROWS(hl, hc, gvec, shoff, scoff, Mr) do { PHASE_IDS const float* hl_ = (hl); const float* hc_ = (hc); const float* gv_ = (gvec); const float* modL_ = WSP(float, WS_MOD) + (size_t)L * 9 * 6144; bf16* XN_ = WSP(bf16, WS_XN); \
            for (int row0_ = gw; row0_ < (Mr); row0_ += 2 * NGW) { const int row1_ = row0_ + NGW; const bool has1_ = row1_ < (Mr); const int rowb_ = has1_ ? row1_ : row0_;     \
                const bool isc0 = row0_ >= ML, isc1 = rowb_ >= ML; const float* hr0 = isc0 ? hc_ + (size_t)(row0_ - ML) * D : hl_ + (size_t)row0_ * D; const float* hr1 = isc1 ? hc_ + (size_t)(rowb_ - ML) * D : hl_ + (size_t)rowb_ * D; \
                const f32x4* xr0 = (const f32x4*)hr0 + lane; const f32x4* xr1 = (const f32x4*)hr1 + lane; f32x4 v0[4], v1[4]; float s0 = 0.f, s1 = 0.f; \
                _Pragma("unroll") for (int j = 0; j < 4; ++j) { v0[j] = xr0[64 * j]; v1[j] = xr1[64 * j]; } \
                _Pragma("unroll") for (int j = 0; j < 4; ++j) { s0 += (v0[j].x * v0[j].x + v0[j].y * v0[j].y) + (v0[j].z * v0[j].z + v0[j].w * v0[j].w); s1 += (v1[j].x * v1[j].x + v1[j].y * v1[j].y) + (v1[j].z * v1[j].z + v1[j].w * v1[j].w); } \
                _Pragma("unroll") for (int o_ = 1; o_ < 64; o_ <<= 1) { s0 += __shfl_xor(s0, o_); s1 += __shfl_xor(s1, o_); } \
                const float rstd0 = rsqrtf(s0 * (1.0f / D) + EPS), rstd1 = rsqrtf(s1 * (1.0f / D) + EPS); const int mi0 = isc0 ? 8 : (row0_ >> 12), mi1 = isc1 ? 8 : (rowb_ >> 12); \
                const f32x4* gr = (const f32x4*)gv_ + lane; \
                const f32x4* sh0 = (const f32x4*)(modL_ + mi0 * 6144 + (shoff)) + lane; const f32x4* sc0 = (const f32x4*)(modL_ + mi0 * 6144 + (scoff)) + lane; \
                const f32x4* sh1 = (const f32x4*)(modL_ + mi1 * 6144 + (shoff)) + lane; const f32x4* sc1 = (const f32x4*)(modL_ + mi1 * 6144 + (scoff)) + lane; \
                unsigned long long* o80 = (unsigned long long*)(XN_ + (size_t)row0_ * D) + lane; unsigned long long* o81 = (unsigned long long*)(XN_ + (size_t)rowb_ * D) + lane; \
                _Pragma("unroll") for (int j = 0; j < 4; ++j) { const f32x4 gg = gr[64 * j]; const f32x4 y0 = v0[j] * rstd0 * gg * (sc0[64 * j] + 1.0f) + sh0[64 * j]; \
                    o80[64 * j] = (unsigned long long)pk2(y0.x, y0.y) | ((unsigned long long)pk2(y0.z, y0.w) << 32); \
                    if (has1_) { const f32x4 y1 = v1[j] * rstd1 * gg * (sc1[64 * j] + 1.0f) + sh1[64 * j]; o81[64 * j] = (unsigned long long)pk2(y1.x, y1.y) | ((unsigned long long)pk2(y1.z, y1.w) << 32); } } } } while (0)
template <int LL, int PART> __device__ __forceinline__ void convert_weights(LAS unsigned char* lds, const int G, const int bx, const int vcu) {
    constexpr int kind = LL % 3, slot = LL / 3; const int NGW = G * 8;
    PHASE_IDS
    unsigned char* ws = PWS();
    bf16* W_in = (bf16*)(ws + WS_W + W_IN); bf16* W_b = (bf16*)(ws + WS_W + W_B); bf16* W_c = (bf16*)(ws + WS_W + W_C); bf16* W_out = (bf16*)(ws + WS_W + W_OUT); bf16* W_gu = (bf16*)(ws + WS_W + W_GU); bf16* W_dn = (bf16*)(ws + WS_W + W_DN);
    (void)W_b; (void)W_c;
    LAS float* scr = (LAS float*)(lds + wave * 16384);
    const float* fg = PF(I_FWG) + (size_t)LL * D * FF; const float* fu = PF(I_FWU) + (size_t)LL * D * FF; const float* fd = PF(I_FWD) + (size_t)LL * FF * D;
    int total = 0;
    if (PART != 2) { total += (D / 64) * (2 * FF / 32);
        if (kind == 0) total += (D / 64) * (3072 / 32) + (D / 64) * (D / 32);
        else if (kind == 1) total += (D / 64) * (1280 / 32) + (768 / 64) * (1536 / 32) + (256 / 64) * (2048 / 32) + (D / 64) * (D / 32);
        else total += (D / 64) * (3072 / 32) + (D / 64) * (D / 32); }
    if (PART != 1) total += (FF / 64) * (D / 32);
    for (int it = gw; it < total; it += NGW) {
        int r = it;
        if (PART != 1) { CONV_MAT(WK_IDENT, fd, fd, D, FF, D, nullptr, W_dn) }
        if (PART != 2) {
            CONV_MAT(WK_GU, fg, fu, FF, D, 2 * FF, nullptr, W_gu)
            if (kind == 0) {
                CONV_MAT(WK_CONV_IN, PF(I_CWIN) + (size_t)slot * D * 3072, nullptr, 3072, D, 3072, nullptr, W_in)
                CONV_MAT(WK_IDENT, PF(I_CWOUT) + (size_t)slot * D * D, nullptr, D, D, D, nullptr, W_out)
            } else if (kind == 1) {
                CONV_MAT(WK_MLA_IN, PF(I_MWIN), nullptr, 1056, D, 1280, nullptr, W_in)
                CONV_MAT(WK_MLA_QUP, PF(I_MWQUP), nullptr, 1536, 768, 1536, PF(I_MQNG), W_b)
                CONV_MAT(WK_MLA_KVUP, PF(I_MWKVUP), nullptr, 2048, 256, 2048, PF(I_MKVNG), W_c)
                CONV_MAT(WK_IDENT, PF(I_MWOUT), nullptr, D, D, D, nullptr, W_out)
            } else {
                CONV_MAT(WK_PAIR64, PF(I_DWIN), nullptr, 3072, D, 3072, nullptr, W_in)
                CONV_MAT(WK_IDENT, PF(I_DWOUT), nullptr, D, D, D, nullptr, W_out)
            }
        }
    }
}
template <int L> __device__ __forceinline__ void layer_fn(LAS unsigned char* lds, const int G, const int bx, const int vcu, const XcdBarrier& xbar) {
    const int NGW = G * 8, GS = G * 512;
    {
        constexpr int kind = L % 3, slot = L / 3; constexpr bool last = (L == 3);
        constexpr int Mrows = last ? ML : MT;
        constexpr int Mffn = (L >= 2) ? ML : MT;
        if constexpr (L > 0) convert_weights<L, 2>(lds, G, bx, vcu);
        NORM_ROWS((L == 0) ? PF(I_X) : (const float*)POUT(), (L == 0) ? PF(I_CTX) : WSP(const float, WS_HCTX), PF(I_NMG) + L * D, 0, 1024, Mrows);
        GRID_SYNC();
#ifdef DBG
        if constexpr (L == 0) { PHASE_IDS unsigned char* ws = PWS(); const unsigned sidx = (unsigned)gtid;
            { const int l = sidx & 3, j = (sidx >> 2) % 9, n = hsh(sidx) % 6144; const float* cv = j < 8 ? PF(I_C) + j * 1024 : PF(I_CCTX); const float* mw = PF(I_MODW) + (size_t)l * 1024 * 6144 + n;
              float ref = PF(I_MODB)[l * 6144 + n]; for (int k = 0; k < 1024; ++k) ref += silu_x(cv[k]) * mw[(size_t)k * 6144];
              if (dbg_bad(WSP(float, WS_MOD)[(size_t)(l * 9 + j) * 6144 + n], ref)) dbg_flag(ws, 0); }
            { const int row = hsh(sidx + 11u) % MT, col = hsh(sidx + 7777u) % 1024; const bool isc = row >= ML; const float* hr = isc ? PF(I_CTX) + (size_t)(row - ML) * D : PF(I_X) + (size_t)row * D; const int mi = isc ? 8 : (row >> 12);
              float ss = 0.f; for (int k = 0; k < 1024; ++k) ss += hr[k] * hr[k]; const float rstd = 1.0f / sqrtf(ss / 1024.0f + 1e-6f); const float* md = WSP(float, WS_MOD) + mi * 6144;
              const float ref = hr[col] * rstd * PF(I_NMG)[col] * (1.0f + md[1024 + col]) + md[col];
              if (dbg_bad(h2f(WSP(bf16, WS_XN) + (size_t)row * D + col), ref)) dbg_flag(ws, 1); } }
        GRID_SYNC();
#endif
        if constexpr (kind == 0) {
            GEMM_PHASE(0, pg8::EpiPair<0>, WSP(bf16, WS_XN), D, WSP(bf16, WS_W + W_IN), Mrows, 3072, D, WSP(bf16, WS_BIG));
            GRID_SYNC();
#ifdef DBG
            if constexpr (L == 0) { PHASE_IDS unsigned char* ws = PWS(); const unsigned sidx = (unsigned)gtid; const int row = hsh(sidx + 5u) % MT, col = hsh(sidx * 3u + 1u) % 1024;
                const bf16* xr = WSP(bf16, WS_XN) + (size_t)row * D; const float* w = PF(I_CWIN) + col; float b = 0.f, c = 0.f, u = 0.f;
                for (int k = 0; k < 1024; ++k) { const float a = h2f(xr + k); b += a * w[(size_t)k * 3072]; c += a * w[(size_t)k * 3072 + 1024]; u += a * w[(size_t)k * 3072 + 2048]; }
                const bf16* pr = WSP(bf16, WS_BIG) + (size_t)row * 2048;
                if (dbg_bad(h2f(pr + col), b) || dbg_bad(h2f(pr + 1024 + col), c * u)) dbg_flag(ws, 2); }
        GRID_SYNC();
#endif
            { PHASE_IDS const float* ck = PF(I_CK) + (size_t)slot * 3 * D; const float* cb = PF(I_CB) + (size_t)slot * D; const bf16* BIG = WSP(bf16, WS_BIG); bf16* XN = WSP(bf16, WS_XN);
              for (int idx = gtid; idx < Mrows * 128; idx += GS) { const int row = idx >> 7, c8 = (idx & 127) * 8;
                  const bool isc = row >= ML; const int t = isc ? ((row - ML) & 255) : (row & 4095); const int tmax = isc ? 255 : 4095;
                  const bf16* pr = BIG + (size_t)row * 2048 + c8;
                  const v4u bb = *(const v4u*)pr; const v4u z0 = *(const v4u*)(pr + 1024);
                  v4u zm = (v4u){0u, 0u, 0u, 0u}, zp = zm; if (t > 0) zm = *(const v4u*)(pr + 1024 - 2048); if (t < tmax) zp = *(const v4u*)(pr + 1024 + 2048);
                  const f32x4 k0a = *(const f32x4*)(ck + c8), k0b = *(const f32x4*)(ck + c8 + 4), k1a = *(const f32x4*)(ck + D + c8), k1b = *(const f32x4*)(ck + D + c8 + 4), k2a = *(const f32x4*)(ck + 2 * D + c8), k2b = *(const f32x4*)(ck + 2 * D + c8 + 4);
                  const f32x4 cba = *(const f32x4*)(cb + c8), cbb = *(const f32x4*)(cb + c8 + 4);
                  v4u ov;
                  { float y0, y1;
                    y0 = bflo(bb.x) * (k0a[0] * bflo(zm.x) + k1a[0] * bflo(z0.x) + k2a[0] * bflo(zp.x) + cba[0]); y1 = bfhi(bb.x) * (k0a[1] * bfhi(zm.x) + k1a[1] * bfhi(z0.x) + k2a[1] * bfhi(zp.x) + cba[1]); ov.x = pk2(y0, y1);
                    y0 = bflo(bb.y) * (k0a[2] * bflo(zm.y) + k1a[2] * bflo(z0.y) + k2a[2] * bflo(zp.y) + cba[2]); y1 = bfhi(bb.y) * (k0a[3] * bfhi(zm.y) + k1a[3] * bfhi(z0.y) + k2a[3] * bfhi(zp.y) + cba[3]); ov.y = pk2(y0, y1);
                    y0 = bflo(bb.z) * (k0b[0] * bflo(zm.z) + k1b[0] * bflo(z0.z) + k2b[0] * bflo(zp.z) + cbb[0]); y1 = bfhi(bb.z) * (k0b[1] * bfhi(zm.z) + k1b[1] * bfhi(z0.z) + k2b[1] * bfhi(zp.z) + cbb[1]); ov.z = pk2(y0, y1);
                    y0 = bflo(bb.w) * (k0b[2] * bflo(zm.w) + k1b[2] * bflo(z0.w) + k2b[2] * bflo(zp.w) + cbb[2]); y1 = bfhi(bb.w) * (k0b[3] * bfhi(zm.w) + k1b[3] * bfhi(z0.w) + k2b[3] * bfhi(zp.w) + cbb[3]); ov.w = pk2(y0, y1); }
                  *(v4u*)(XN + (size_t)row * D + c8) = ov; } }
            GRID_SYNC();
#ifdef DBG
            if constexpr (L == 0) { PHASE_IDS unsigned char* ws = PWS(); const unsigned sidx = (unsigned)gtid; const int row = hsh(sidx + 9u) % MT, col = hsh(sidx * 5u + 2u) % 1024;
                const bool isc = row >= ML; const int t = isc ? ((row - ML) & 255) : (row & 4095); const int tmax = isc ? 255 : 4095; const bf16* pr = WSP(bf16, WS_BIG) + (size_t)row * 2048;
                const float* ck = PF(I_CK); float y = PF(I_CB)[col] + ck[D + col] * h2f(pr + 1024 + col); if (t > 0) y += ck[col] * h2f(pr - 2048 + 1024 + col); if (t < tmax) y += ck[2 * D + col] * h2f(pr + 2048 + 1024 + col);
                if (dbg_bad(h2f(WSP(bf16, WS_XN) + (size_t)row * D + col), h2f(pr + col) * y)) dbg_flag(ws, 3); }
        GRID_SYNC();
#endif
        } else if constexpr (kind == 1) {
            GEMM_PHASE(1, pg8::EpiMlaIn, WSP(bf16, WS_XN), D, WSP(bf16, WS_W + W_IN), MT, 1280, D, WSP(bf16, WS_BIG), WSP(bf16, WS_BIG + BIG_KVL), WSP(bf16, WS_BIG + BIG_KPR), WSP(float, WS_ROWSS));
            GRID_SYNC();
            GEMM_PHASE(2, pg8::EpiMlaQ, WSP(bf16, WS_BIG), 768, WSP(bf16, WS_W + W_B), MT, 1536, 768, WSP(bf16, WS_BIG + BIG_Q), WSP(float, WS_ROWSS), PF(I_MQNN), PF(I_MQNR), WSP(float, WS_TAB), rsqrtf(96.0f) * LOG2E);
            GEMM_PHASE(3, pg8::EpiMlaKV, WSP(bf16, WS_BIG + BIG_KVL), 256, WSP(bf16, WS_W + W_C), MT, 2048, 256, WSP(bf16, WS_KV), WSP(bf16, WS_KV) + (size_t)MT * 1024, WSP(float, WS_ROWSS) + 3 * MT, PF(I_MKNN));
            if constexpr (!((KNOCK >> 12) & 1)) { PHASE_IDS const bf16* KPR = WSP(bf16, WS_BIG + BIG_KPR); bf16* KPE = WSP(bf16, WS_KPE); const float* tabM = WSP(float, WS_TAB); const float* kg = PF(I_MKNR);
              for (int row = gtid; row < MT; row += GS) {
                const v4u* src = (const v4u*)(KPR + (size_t)row * 32);
                float v[32];
#pragma unroll
                for (int q = 0; q < 4; ++q) { const v4u wv = src[q]; v[8 * q] = bflo(wv.x); v[8 * q + 1] = bfhi(wv.x); v[8 * q + 2] = bflo(wv.y); v[8 * q + 3] = bfhi(wv.y); v[8 * q + 4] = bflo(wv.z); v[8 * q + 5] = bfhi(wv.z); v[8 * q + 6] = bflo(wv.w); v[8 * q + 7] = bfhi(wv.w); }
                float ss = 0.f;
#pragma unroll
                for (int j = 0; j < 32; ++j) ss += v[j] * v[j];
                const float inv = rsqrtf(ss * (1.0f / 32.0f) + EPS);
#pragma unroll
                for (int j = 0; j < 32; ++j) v[j] = v[j] * inv * kg[j];
                if (row < ML) { const int t = row & 4095;
#pragma unroll
                    for (int hf = 0; hf < 2; ++hf) { const int pos = hf ? (t & 63) : (t >> 6);
#pragma unroll
                        for (int i = 0; i < 8; ++i) { const float c = tabM[pos * 8 + i], sn = tabM[512 + pos * 8 + i]; const float a = v[16 * hf + i], bq = v[16 * hf + 8 + i];
                            v[16 * hf + i] = a * c - bq * sn; v[16 * hf + 8 + i] = bq * c + a * sn; } } }
                v4u* dst = (v4u*)(KPE + (size_t)row * 32);
#pragma unroll
                for (int q = 0; q < 4; ++q) { v4u wv; wv.x = pk2(v[8 * q], v[8 * q + 1]); wv.y = pk2(v[8 * q + 2], v[8 * q + 3]); wv.z = pk2(v[8 * q + 4], v[8 * q + 5]); wv.w = pk2(v[8 * q + 6], v[8 * q + 7]); dst[q] = wv; } } }
            GRID_SYNC();
#ifdef DBG
            { PHASE_IDS unsigned char* ws = PWS(); const unsigned sidx = (unsigned)gtid; unsigned short* sn = (unsigned short*)(ws + DBG_SNAP);
              const int row = (sidx & 1) ? ML + (int)(hsh(sidx + 41u) % MC) : (int)(hsh(sidx + 41u) % ML); const int col = hsh(sidx + 43u) % 1024;
              sn[sidx * 4 + 0] = WSP(bf16, WS_KV)[(size_t)row * 1024 + col]; sn[sidx * 4 + 1] = (WSP(bf16, WS_KV) + (size_t)MT * 1024)[(size_t)row * 1024 + col];
              sn[sidx * 4 + 2] = WSP(bf16, WS_KPE)[(size_t)row * 32 + (col & 31)]; sn[sidx * 4 + 3] = WSP(bf16, WS_BIG + BIG_Q)[(size_t)row * 1536 + col]; }
#endif
            if constexpr (!((KNOCK >> 10) & 1)) { AttnP<96, 64, false> P{WSP(bf16, WS_BIG + BIG_Q), 1536, WSP(bf16, WS_KV), 1024, WSP(bf16, WS_KPE), WSP(bf16, WS_KV) + (size_t)MT * 1024, 1024, WSP(bf16, WS_XN), 0.f, 0.f, (const float*)(PWS() + WS_TAB + 262144)};
              for (int rep_ = 0; rep_ < ATT_REP; ++rep_)
              for (int u = vcu; u < 2048 + 128; u += G) {
                  const bool cq = u >= 2048; const int bh = cq ? u - 2048 : (u >> 4); const int bb = bh >> 4, hh_ = bh & 15; const int qrow0 = cq ? ML + bb * CTXL : bb * SEQ + (u & 15) * 256;
                  attn_unit<96, 64, false>(lds, P, bb, hh_, qrow0, cq ? 4 : 68); } }
            GRID_SYNC();
#ifdef DBG
            { PHASE_IDS unsigned char* ws = PWS(); const unsigned sidx = (unsigned)gtid;
              if (sidx < 32u) { const int q = sidx; const float* dmp = (const float*)(ws + WS_TAB + 262144); float m = -1e30f;
                for (int tt = 0; tt < 4; ++tt) for (int key = 0; key < 64; ++key) m = fmaxf(m, dmp[tt * 2048 + q * 64 + key]);
                float l = 0.f, l0 = 0.f; for (int tt = 0; tt < 4; ++tt) for (int key = 0; key < 64; ++key) { const float p = exp2f(dmp[tt * 2048 + q * 64 + key] - m); l += p; if (((key >> 2) & 1) == 0) l0 += p; }
                const float kl = dmp[4 * 2048 + q], km = dmp[4 * 2048 + 32 + q], kl0 = dmp[4 * 2048 + 64 + q]; unsigned* cw = (unsigned*)(ws + DBG_OFF) + 16;
                if (fabsf(kl - l) > 0.01f * l) atomicAdd(cw + 0, 1u); if (fabsf(km - m) > 0.01f) atomicAdd(cw + 1, 1u); if (fabsf(kl0 - l0) > 0.01f * l0) atomicAdd(cw + 2, 1u); if (fabsf(kl - 2.0f * kl0) < 0.001f * kl) atomicAdd(cw + 3, 1u); }
              { unsigned short* sn = (unsigned short*)(ws + DBG_SNAP); const int row = (sidx & 1) ? ML + (int)(hsh(sidx + 41u) % MC) : (int)(hsh(sidx + 41u) % ML); const int col = hsh(sidx + 43u) % 1024; unsigned* cw = (unsigned*)(ws + DBG_OFF) + 8;
                if (sn[sidx * 4 + 0] != WSP(bf16, WS_KV)[(size_t)row * 1024 + col]) atomicAdd(cw + 0, 1u);
                if (sn[sidx * 4 + 1] != (WSP(bf16, WS_KV) + (size_t)MT * 1024)[(size_t)row * 1024 + col]) atomicAdd(cw + 1, 1u);
                if (sn[sidx * 4 + 2] != WSP(bf16, WS_KPE)[(size_t)row * 32 + (col & 31)]) atomicAdd(cw + 2, 1u);
                if (sn[sidx * 4 + 3] != WSP(bf16, WS_BIG + BIG_Q)[(size_t)row * 1536 + col]) atomicAdd(cw + 3, 1u);
                if ((sidx & 1) && (sn[sidx * 4 + 0] != WSP(bf16, WS_KV)[(size_t)row * 1024 + col] || sn[sidx * 4 + 1] != (WSP(bf16, WS_KV) + (size_t)MT * 1024)[(size_t)row * 1024 + col])) atomicAdd(cw + 4, 1u); }
            }
        GRID_SYNC();
#endif
        } else {
            GEMM_PHASE(4, pg8::EpiDiff, WSP(bf16, WS_XN), D, WSP(bf16, WS_W + W_IN), MT, 3072, D, WSP(bf16, WS_BIG), PF(I_DQNG), PF(I_DKNG), WSP(float, WS_TAB) + 1024, 0.125f * LOG2E);
            GRID_SYNC();
            if constexpr (!((KNOCK >> 11) & 1)) { float lam; { PHASE_IDS const float d1 = wave_sum(PF(I_DLQ1)[lane] * PF(I_DLK1)[lane]), d2 = wave_sum(PF(I_DLQ2)[lane] * PF(I_DLK2)[lane]); lam = __expf(d1) - __expf(d2); }
              const float lam_init = 0.8f - 0.6f * 0.5488116360940264f;
              lam = __builtin_bit_cast(float, __builtin_amdgcn_readfirstlane(__builtin_bit_cast(int, lam))) + lam_init;
              bf16* BIG = WSP(bf16, WS_BIG);
              AttnP<64, 128, true> P{BIG, 3072, BIG + 1024, 3072, nullptr, BIG + 2048, 3072, WSP(bf16, WS_XN), lam, 1.0f - lam_init, PF(I_DSUBG)};
              for (int rep_ = 0; rep_ < ATT_REP; ++rep_)
              for (int u = vcu; u < 2048; u += G) { const int bh = u >> 5, qb = u & 31; attn_unit<64, 128, true>(lds, P, bh >> 3, bh & 7, (bh >> 3) * SEQ + qb * 128, 68); } }
            GRID_SYNC();
        }
        GEMM_PHASE(5, pg8::EpiResid, WSP(bf16, WS_XN), D, WSP(bf16, WS_W + W_OUT), Mffn, D, D, (L == 0) ? PF(I_X) : (const float*)POUT(), (L == 0) ? PF(I_CTX) : WSP(const float, WS_HCTX), POUT(), WSP(float, WS_HCTX), WSP(float, WS_MOD) + (size_t)L * 9 * 6144 + 2048);
        GRID_SYNC();
#ifdef DBG
        if constexpr (L == 0) { PHASE_IDS unsigned char* ws = PWS(); const unsigned sidx = (unsigned)gtid; const int row = hsh(sidx + 13u) % MT, col = hsh(sidx * 7u + 3u) % 1024; const bool isc = row >= ML; const int mi = isc ? 8 : (row >> 12);
            const bf16* xr = WSP(bf16, WS_XN) + (size_t)row * D; const float* w = PF(I_CWOUT) + col; float o = 0.f; for (int k = 0; k < 1024; ++k) o += h2f(xr + k) * w[(size_t)k * 1024];
            const float base = isc ? PF(I_CTX)[(size_t)(row - ML) * D + col] : PF(I_X)[(size_t)row * D + col]; const float got = isc ? WSP(float, WS_HCTX)[(size_t)(row - ML) * D + col] : POUT()[(size_t)row * D + col];
            if (dbg_bad(got, base + WSP(float, WS_MOD)[mi * 6144 + 2048 + col] * o)) dbg_flag(ws, 3); }
        GRID_SYNC();
#endif
        NORM_ROWS((const float*)POUT(), WSP(const float, WS_HCTX), PF(I_NFG) + L * D, 3072, 4096, Mffn);
        GRID_SYNC();
        GEMM_PHASE(6, pg8::EpiPair<1>, WSP(bf16, WS_XN), D, WSP(bf16, WS_W + W_GU), Mffn, 2 * FF, D, WSP(bf16, WS_BIG));
        GRID_SYNC();
#ifdef DBG
        if constexpr (L == 0) { PHASE_IDS unsigned char* ws = PWS(); const unsigned sidx = (unsigned)gtid; const int row = hsh(sidx + 17u) % MT, col = hsh(sidx * 11u + 4u) % FF;
            const bf16* xr = WSP(bf16, WS_XN) + (size_t)row * D; const float* wg = PF(I_FWG) + col; const float* wu = PF(I_FWU) + col; float g = 0.f, u = 0.f;
            for (int k = 0; k < 1024; ++k) { const float a = h2f(xr + k); g += a * wg[(size_t)k * FF]; u += a * wu[(size_t)k * FF]; }
            if (dbg_bad(h2f(WSP(bf16, WS_BIG) + (size_t)row * FF + col), silu_x(g) * u)) dbg_flag(ws, 4);
            const int row2 = hsh(sidx + 19u) % MT, col2 = hsh(sidx * 13u + 5u) % 1024; const bool isc = row2 >= ML;
            ((float*)(ws + DBG_SNAP))[sidx] = isc ? WSP(float, WS_HCTX)[(size_t)(row2 - ML) * D + col2] : POUT()[(size_t)row2 * D + col2]; }
        GRID_SYNC();
#endif
        GEMM_PHASE(7, pg8::EpiResid, WSP(bf16, WS_BIG), FF, WSP(bf16, WS_W + W_DN), Mffn, D, FF, (const float*)POUT(), WSP(const float, WS_HCTX), POUT(), WSP(float, WS_HCTX), WSP(float, WS_MOD) + (size_t)L * 9 * 6144 + 5120);
        if constexpr (L < 3) convert_weights<L + 1, 1>(lds, G, bx, vcu);
        if (L < 3) GRID_SYNC();
#ifdef DBG
        if constexpr (L == 0) { PHASE_IDS unsigned char* ws = PWS(); const unsigned sidx = (unsigned)gtid; const int row2 = hsh(sidx + 19u) % MT, col2 = hsh(sidx * 13u + 5u) % 1024; const bool isc = row2 >= ML; const int mi = isc ? 8 : (row2 >> 12);
            const bf16* hr = WSP(bf16, WS_BIG) + (size_t)row2 * FF; const float* w = PF(I_FWD) + col2; float o = 0.f; for (int k = 0; k < FF; ++k) o += h2f(hr + k) * w[(size_t)k * 1024];
            const float got = isc ? WSP(float, WS_HCTX)[(size_t)(row2 - ML) * D + col2] : POUT()[(size_t)row2 * D + col2];
            if (dbg_bad(got, ((float*)(ws + DBG_SNAP))[sidx] + WSP(float, WS_MOD)[mi * 6144 + 5120 + col2] * o)) dbg_flag(ws, 4); }
        GRID_SYNC();
#endif
    }
}

__global__ void __launch_bounds__(512, 2) fwd_mega(Args args) {
    extern __shared__ __attribute__((aligned(16))) unsigned char lds_raw[];
    cg::grid_group grid = cg::this_grid();
    LAS unsigned char* lds = (LAS unsigned char*)lds_raw;
    const int G = gridDim.x, bx = blockIdx.x;
    const int vcu = (G % 8 == 0) ? (bx % 8) * (G / 8) + bx / 8 : bx;
    const int NGW = G * 8, GS = G * 512;
    if (threadIdx.x < 2) ((volatile LAS unsigned*)(lds + BARGEN_OFF))[threadIdx.x] = 0u;
    __syncthreads();
    const XcdBarrier xbar = xcd_barrier_post((unsigned*)(PWS() + WS_BAR), (volatile LAS unsigned*)(lds + BARGEN_OFF));
    grid.sync();
    {
        PHASE_IDS
        unsigned char* ws = PWS();
        float* rowss = (float*)(ws + WS_ROWSS); float* tabM = (float*)(ws + WS_TAB); float* tabD = tabM + 1024; float* MOD = (float*)(ws + WS_MOD);
        const float* cvec = PF(I_C); const float* cctx = PF(I_CCTX); const float* mod_w = PF(I_MODW); const float* mod_b = PF(I_MODB);
        LAS float* sl = (LAS float*)lds; LAS float* red = sl + 9 * 1024;
        for (int i = tid; i < 9 * 1024; i += 512) { const int j = i >> 10, k = i & 1023; const float v = j < 8 ? cvec[j * 1024 + k] : cctx[k]; sl[i] = v / (1.0f + __expf(-v)); }
        __syncthreads();
        for (int item = bx; item < 4 * 96; item += G) {
            const int l = item / 96, n0 = (item % 96) * 64;
            const float* Wp = mod_w + (size_t)l * 1024 * 6144 + n0 + lane; const int k0 = wave * 128;
            float a0 = 0.f, a1 = 0.f, a2 = 0.f, a3 = 0.f, a4 = 0.f, a5 = 0.f, a6 = 0.f, a7 = 0.f, a8 = 0.f;
#pragma unroll 32
            for (int kk = 0; kk < 128; ++kk) { const float wv = Wp[(size_t)(k0 + kk) * 6144]; const LAS float* sp = sl + k0 + kk;
                a0 += sp[0] * wv; a1 += sp[1024] * wv; a2 += sp[2048] * wv; a3 += sp[3072] * wv; a4 += sp[4096] * wv; a5 += sp[5120] * wv; a6 += sp[6144] * wv; a7 += sp[7168] * wv; a8 += sp[8192] * wv; }
            LAS float* rp = red + wave * 9 * 64 + lane;
            rp[0] = a0; rp[64] = a1; rp[128] = a2; rp[192] = a3; rp[256] = a4; rp[320] = a5; rp[384] = a6; rp[448] = a7; rp[512] = a8;
            __syncthreads();
            for (int o = tid; o < 9 * 64; o += 512) { const int j = o >> 6, ln = o & 63; float s = mod_b[l * 6144 + n0 + ln];
#pragma unroll
                for (int w8 = 0; w8 < 8; ++w8) s += red[(w8 * 9 + j) * 64 + ln];
                MOD[(size_t)(l * 9 + j) * 6144 + n0 + ln] = s; }
            __syncthreads();
        }
        for (int i = gtid; i < 4 * MT; i += GS) rowss[i] = 0.f;
#ifdef DBG
        if (gtid < 64) ((unsigned*)(ws + DBG_OFF))[gtid] = 0u;
#endif
        if (bx == G - 1) {
            for (int i = tid; i < 512 + 1024; i += 512) {
                const bool dm = i >= 512; const int ii = dm ? i - 512 : i; const int nf = dm ? 16 : 8; const int pos = ii / nf, fi = ii % nf;
                const double base = dm ? 0.5623413251903491 : 0.31622776601683794;
                double f = 1.0; for (int q = 0; q < fi; ++q) f *= base;
                double a = (double)pos * f;
                const double twopi = 6.283185307179586476925; const double kq = __builtin_rint(a / twopi); a -= kq * twopi;
                double sn = a, cs = 1.0, term_s = a, term_c = 1.0; const double a2 = a * a;
                for (int q = 1; q < 16; ++q) { term_c *= -a2 / (double)((2 * q - 1) * (2 * q)); term_s *= -a2 / (double)((2 * q) * (2 * q + 1)); cs += term_c; sn += term_s; }
                float* tb = dm ? tabD : tabM; const int half = dm ? 1024 : 512;
                tb[pos * nf + fi] = (float)cs; tb[half + pos * nf + fi] = (float)sn;
            }
        }
    }
    convert_weights<0, 0>(lds, G, bx, vcu);
    GRID_SYNC();

    layer_fn<0>(lds, G, bx, vcu, xbar);
    layer_fn<1>(lds, G, bx, vcu, xbar);
    layer_fn<2>(lds, G, bx, vcu, xbar);
    layer_fn<3>(lds, G, bx, vcu, xbar);
#ifdef DBG
    GRID_SYNC();
    if (blockIdx.x == 0 && threadIdx.x == 0) { volatile unsigned* dw = (volatile unsigned*)(PWS() + DBG_OFF); unsigned m = 0; const unsigned nl = dw[4], fl = dw[5], nc = dw[6], fc = dw[7];
        m = 0; { m = (dw[16] ? 1u : 0u) + (dw[17] ? 2u : 0u) + (dw[18] ? 4u : 0u) + (dw[19] > 16u ? 8u : 0u); } (void)nc; (void)fc; (void)nl; (void)fl; POUT()[0] += 1000.0f * (float)m; }
#endif
}

extern "C" void kernel_launch(void* const* d_in, const int* in_sizes, int n_in, void* d_out, int out_size, void* d_ws, size_t ws_size, hipStream_t stream) {
    static int grid_blocks = 0;
    if (grid_blocks == 0) {
        if (n_in != 34 || ws_size < WS_END) { fprintf(stderr, "kernel_launch: unexpected n_in %d or ws_size %zu (< %zu)\n", n_in, ws_size, (size_t)WS_END); grid_blocks = -1; return; }
        int dev = 0, cus = 0, per_cu = 0;
        (void)hipGetDevice(&dev);
        (void)hipDeviceGetAttribute(&cus, hipDeviceAttributeMultiprocessorCount, dev);
        (void)hipFuncSetAttribute((const void*)fwd_mega, hipFuncAttributeMaxDynamicSharedMemorySize, LDS_BYTES);
        (void)hipOccupancyMaxActiveBlocksPerMultiprocessor(&per_cu, (const void*)fwd_mega, 512, LDS_BYTES);
        if (per_cu < 1) per_cu = 1;
        grid_blocks = cus * per_cu;
        fprintf(stderr, "grid %d (cus %d per_cu %d) ws_size %zu\n", grid_blocks, cus, per_cu, ws_size);
    }
    if (grid_blocks < 0) return;
    (void)hipMemsetAsync((char*)d_ws + WS_BAR, 0, XCD_BAR_WORDS * 4, stream);
    Args a{};
    for (int i = 0; i < 34; ++i) a.in[i] = (const float*)d_in[i];
    a.out = (float*)d_out; a.ws = (unsigned char*)d_ws;
    void* kargs[] = {&a};
    hipError_t e = hipLaunchCooperativeKernel((void*)fwd_mega, dim3(grid_blocks), dim3(512), kargs, LDS_BYTES, stream);
    if (e != hipSuccess) fprintf(stderr, "cooperative launch failed: %s (grid %d)\n", hipGetErrorString(e), grid_blocks);
}
```

```cpp
#ifndef ATT_REP
#define ATT_REP 1
#endif
#include <hip/hip_runtime.h>
#include <hip/hip_cooperative_groups.h>
#include <cstdio>
#include <cstdint>
namespace cg = cooperative_groups;
namespace pg8 {
#define PG8_LAS __attribute__((address_space(3)))
typedef unsigned short bf16_t;
typedef short bf16x8 __attribute__((ext_vector_type(8)));
typedef float f32x4 __attribute__((ext_vector_type(4)));
typedef unsigned u32x4 __attribute__((ext_vector_type(4)));
typedef _Float16 f16x8 __attribute__((ext_vector_type(8)));
typedef _Float16 f16x2 __attribute__((ext_vector_type(2)));
typedef float f32x2v __attribute__((ext_vector_type(2)));
constexpr int BM = 256, BK = 64, HALF = 128, HTB = HALF * BK * 2  , STAGE_BYTES = 8 * HTB, NXCD = 8, WGM = 8;

__host__ __device__ __forceinline__ int lds_byte(int r, int c) { const int st = (r >> 4) * 2 + (c >> 5), rr = r & 15, cc = c & 31, ob = rr * 64 + cc * 2; return st * 1024 + (ob ^ (((ob >> 9) & 1) << 5)); }
__host__ __device__ __forceinline__ void stage_rc(int b, int& R, int& C) { const int st = b / 1024, sb = b % 1024, swz = sb ^ (((sb >> 9) & 1) << 5); R = (st >> 1) * 16 + swz / 64; C = (st & 1) * 32 + (swz % 64) / 2; }
__host__ __device__ __forceinline__ int perm32(int rho) { const int n = rho >> 4, i = rho & 15; return 8 * (i >> 2) + 4 * n + (i & 3); }

struct Unit { int pm, pn; };
struct Gemm { const bf16_t* A; const bf16_t* Bt; int M, N, K, lda; };

struct StaticOrder {
    int nM, nN, nwg, G, c;
    __host__ __device__ void init(int M, int N, int G_, int c_) { nM = M / BM; nN = N / BM; nwg = nM * nN; G = G_; c = c_; }
    __host__ __device__ bool next(int i, Unit& u) const {
        const long L = (long)i * G + c; if (L >= nwg) return false;
        int wgid = (int)L; { const int q = nwg / NXCD, r = nwg % NXCD, xcd = wgid % NXCD, off = wgid / NXCD; wgid = (xcd < r ? xcd * (q + 1) : r * (q + 1) + (xcd - r) * q) + off; }
        const int nig = WGM * nN, gid = wgid / nig, fm = gid * WGM, gsz = (nM - fm) < WGM ? (nM - fm) : WGM;
        u.pm = fm + ((wgid % nig) % gsz); u.pn = (wgid % nig) / gsz; return true;
    }
    __device__ __forceinline__ void a_ready(const Unit&) const {}
    __device__ __forceinline__ void done(const Unit&) const {}
};

constexpr int ML_ = 32768, MT_ = 34816, DM_ = 1024;
constexpr float EPS_ = 1e-6f;
__device__ __forceinline__ unsigned cvt_pk_bf16(float lo, float hi) { const f32x2v v = {lo, hi}; return __builtin_bit_cast(unsigned, __builtin_convertvector(v, f16x2)); }
__device__ __forceinline__ u32x4 pack8(const f32x4 a, const f32x4 b) { u32x4 w; w.x = cvt_pk_bf16(a[0], a[1]); w.y = cvt_pk_bf16(a[2], a[3]); w.z = cvt_pk_bf16(b[0], b[1]); w.w = cvt_pk_bf16(b[2], b[3]); return w; }
__device__ __forceinline__ float sum4sq(const f32x4 a) { return (a[0] * a[0] + a[1] * a[1]) + (a[2] * a[2] + a[3] * a[3]); }
__device__ __forceinline__ float lanex(float v, int lane, int mask) { return __builtin_bit_cast(float, __builtin_amdgcn_ds_bpermute((lane ^ mask) << 2, __builtin_bit_cast(int, v))); }
__device__ __forceinline__ float red_fq(float s, int fr, int fq) { const int lane = fr | (fq << 4); s += lanex(s, lane, 16); s += lanex(s, lane, 32); return s; }
__device__ __forceinline__ f32x4 shfl4x(const f32x4 v, int fr, int fq, int mask) { const int lane = fr | (fq << 4); f32x4 r; r[0] = lanex(v[0], lane, mask); r[1] = lanex(v[1], lane, mask); r[2] = lanex(v[2], lane, mask); r[3] = lanex(v[3], lane, mask); return r; }
__device__ __forceinline__ float silu_fast(float x) { return x * __builtin_amdgcn_rcpf(1.0f + __builtin_amdgcn_exp2f(-1.4426950408889634f * x)); }

struct EpiResid {
    static constexpr bool PERM = false, AFTER_DRAIN = false;
    const float* base_lat; const float* base_ctx; float* out_lat; float* out_ctx; const float* gate;
    __device__ __forceinline__ void operator()(const f32x4 (&acc)[2][2][4][2], const Unit& u, int wr, int wc, int fr, int fq) const {
        const int rowt = u.pm * BM; const bool isctx = rowt >= ML_;
        const float* base = isctx ? base_ctx - (size_t)ML_ * DM_ : base_lat; float* out = isctx ? out_ctx - (size_t)ML_ * DM_ : out_lat;
        const int mi = isctx ? 8 : (rowt >> 12);
        const int col0 = u.pn * BM + wc * 32 + 4 * fq;
        const float* gp = gate + mi * 6144 + col0;
        f32x4 gv[2][2];
#pragma unroll
        for (int bj = 0; bj < 2; ++bj)
#pragma unroll
            for (int n = 0; n < 2; ++n) gv[bj][n] = *(const f32x4*)(gp + bj * HALF + n * 16);
#pragma unroll
        for (int ai = 0; ai < 2; ++ai)
#pragma unroll
            for (int m = 0; m < 4; ++m) { const size_t off = (size_t)(rowt + ai * HALF + wr * 64 + m * 16 + fr) * DM_ + col0;
#pragma unroll
                for (int bj = 0; bj < 2; ++bj)
#pragma unroll
                    for (int n = 0; n < 2; ++n) { const f32x4 bs = *(const f32x4*)(base + off + bj * HALF + n * 16); *(f32x4*)(out + off + bj * HALF + n * 16) = bs + gv[bj][n] * acc[ai][bj][m][n]; } }
    }
};
template <int MODE> struct EpiPair {
    static constexpr bool PERM = true, AFTER_DRAIN = false;
    bf16_t* O;
    __device__ __forceinline__ void operator()(const f32x4 (&acc)[2][2][4][2], const Unit& u, int wr, int wc, int fr, int fq) const {
        const int row0 = u.pm * BM + wr * 64 + fr;
        constexpr int ldo = MODE == 0 ? 2048 : 2816;
        if (MODE == 0 && u.pn < 4) {
#pragma unroll
            for (int ai = 0; ai < 2; ++ai)
#pragma unroll
                for (int m = 0; m < 4; ++m) { bf16_t* rowp = O + (size_t)(row0 + ai * HALF + m * 16) * ldo + u.pn * BM + wc * 32 + 8 * fq;
#pragma unroll
                    for (int bj = 0; bj < 2; ++bj) *(u32x4*)(rowp + bj * HALF) = pack8(acc[ai][bj][m][0], acc[ai][bj][m][1]); }
        } else {
            const int colo = (MODE == 0 ? 1024 + (u.pn - 4) * 128 : u.pn * 128) + wc * 32 + 8 * fq;
#pragma unroll
            for (int ai = 0; ai < 2; ++ai)
#pragma unroll
                for (int m = 0; m < 4; ++m) { bf16_t* rowp = O + (size_t)(row0 + ai * HALF + m * 16) * ldo + colo;
                    f32x4 r0, r1;
#pragma unroll
                    for (int e = 0; e < 4; ++e) {
                        if (MODE == 0) { r0[e] = acc[ai][0][m][0][e] * acc[ai][1][m][0][e]; r1[e] = acc[ai][0][m][1][e] * acc[ai][1][m][1][e]; }
                        else { r0[e] = silu_fast(acc[ai][0][m][0][e]) * acc[ai][1][m][0][e]; r1[e] = silu_fast(acc[ai][0][m][1][e]) * acc[ai][1][m][1][e]; } }
                    *(u32x4*)rowp = pack8(r0, r1); }
        }
    }
};
struct EpiMlaIn {
    static constexpr bool PERM = true, AFTER_DRAIN = false;
    bf16_t* QL; bf16_t* KVL; bf16_t* KPR; float* rowss;
    __device__ __forceinline__ void operator()(const f32x4 (&acc)[2][2][4][2], const Unit& u, int wr, int wc, int fr, int fq) const {
        const int row0 = u.pm * BM + wr * 64 + fr;
        if (u.pn == 4) {
            if (wc == 0) {
#pragma unroll
                for (int ai = 0; ai < 2; ++ai)
#pragma unroll
                    for (int m = 0; m < 4; ++m) *(u32x4*)(KPR + (size_t)(row0 + ai * HALF + m * 16) * 32 + 8 * fq) = pack8(acc[ai][0][m][0], acc[ai][0][m][1]);
            }
            return;
        }
        bf16_t* O = u.pn < 3 ? QL + u.pn * BM : KVL; const int ldo = u.pn < 3 ? 768 : 256;
#pragma unroll
        for (int ai = 0; ai < 2; ++ai)
#pragma unroll
            for (int m = 0; m < 4; ++m) { const int row = row0 + ai * HALF + m * 16; bf16_t* rowp = O + (size_t)row * ldo + wc * 32 + 8 * fq;
                float s = 0.f;
#pragma unroll
                for (int bj = 0; bj < 2; ++bj) { *(u32x4*)(rowp + bj * HALF) = pack8(acc[ai][bj][m][0], acc[ai][bj][m][1]); s += sum4sq(acc[ai][bj][m][0]) + sum4sq(acc[ai][bj][m][1]); }
                s = red_fq(s, fr, fq);
                if (fq == 0) atomicAdd(rowss + u.pn * MT_ + row, s); }
    }
};
struct EpiMlaQ {
    static constexpr bool PERM = true, AFTER_DRAIN = false;
    bf16_t* Q; const float* rowss; const float* g_nope; const float* g_rope; const float* tab; float scale;
    __device__ __forceinline__ void operator()(const f32x4 (&acc)[2][2][4][2], const Unit& u, int wr, int wc, int fr, int fq) const {
        const int row0 = u.pm * BM + wr * 64 + fr;
        if (u.pn < 4) {
            const int head = 4 * u.pn + wc;
            f32x4 g[2][2];
#pragma unroll
            for (int bj = 0; bj < 2; ++bj)
#pragma unroll
                for (int n = 0; n < 2; ++n) g[bj][n] = *(const f32x4*)(g_nope + 32 * bj + 8 * fq + 4 * n);
#pragma unroll
            for (int ai = 0; ai < 2; ++ai)
#pragma unroll
                for (int m = 0; m < 4; ++m) { const int row = row0 + ai * HALF + m * 16;
                    const float rs = rsqrtf((rowss[row] + rowss[MT_ + row] + rowss[2 * MT_ + row]) * (1.0f / 768.0f) + EPS_);
                    float ss = 0.f;
#pragma unroll
                    for (int bj = 0; bj < 2; ++bj) ss += sum4sq(acc[ai][bj][m][0]) + sum4sq(acc[ai][bj][m][1]);
                    ss = red_fq(ss, fr, fq);
                    const float inv = rs * rsqrtf(rs * rs * ss * (1.0f / 64.0f) + EPS_) * scale;
                    bf16_t* rowp = Q + (size_t)row * 1536 + head * 96 + 8 * fq;
#pragma unroll
                    for (int bj = 0; bj < 2; ++bj) *(u32x4*)(rowp + 32 * bj) = pack8(acc[ai][bj][m][0] * inv * g[bj][0], acc[ai][bj][m][1] * inv * g[bj][1]); }
        } else {
            f32x4 g[2];
#pragma unroll
            for (int n = 0; n < 2; ++n) g[n] = *(const f32x4*)(g_rope + 8 * fq + 4 * n);
            const bool isctx = u.pm * BM >= ML_;
#pragma unroll
            for (int ai = 0; ai < 2; ++ai)
#pragma unroll
                for (int m = 0; m < 4; ++m) { const int row = row0 + ai * HALF + m * 16;
                    const float rs = rsqrtf((rowss[row] + rowss[MT_ + row] + rowss[2 * MT_ + row]) * (1.0f / 768.0f) + EPS_);
                    const int t = row & 4095; const int pos = (fq >> 1) ? (t & 63) : (t >> 6);
                    f32x4 cs[2], sn[2];
#pragma unroll
                    for (int n = 0; n < 2; ++n) { cs[n] = *(const f32x4*)(tab + pos * 8 + 4 * n); sn[n] = *(const f32x4*)(tab + 512 + pos * 8 + 4 * n); }
#pragma unroll
                    for (int bj = 0; bj < 2; ++bj) { const int head = 8 * (u.pn - 4) + 4 * bj + wc;
                        float ss = red_fq(sum4sq(acc[ai][bj][m][0]) + sum4sq(acc[ai][bj][m][1]), fr, fq);
                        const float inv = rs * rsqrtf(rs * rs * ss * (1.0f / 32.0f) + EPS_);
                        f32x4 y[2];
#pragma unroll
                        for (int n = 0; n < 2; ++n) { y[n] = acc[ai][bj][m][n] * inv * g[n];
                            const f32x4 yp = shfl4x(y[n], fr, fq, 16);
                            if (!isctx) y[n] = (fq & 1) ? (y[n] * cs[n] + yp * sn[n]) : (y[n] * cs[n] - yp * sn[n]);
                            y[n] = y[n] * scale; }
                        *(u32x4*)(Q + (size_t)row * 1536 + head * 96 + 64 + 8 * fq) = pack8(y[0], y[1]); } }
        }
    }
};
struct EpiMlaKV {
    static constexpr bool PERM = true, AFTER_DRAIN = false;
    bf16_t* K; bf16_t* V; const float* rowss; const float* g_nope;
    __device__ __forceinline__ void operator()(const f32x4 (&acc)[2][2][4][2], const Unit& u, int wr, int wc, int fr, int fq) const {
        const int row0 = u.pm * BM + wr * 64 + fr; const bool isk = u.pn < 4; const int head = 4 * (u.pn & 3) + wc;
        float eps_l = EPS_; asm volatile("" : "+v"(eps_l));
        bf16_t* obase = (isk ? K : V) + head * 64 + 8 * fq;
#pragma unroll
        for (int ai = 0; ai < 2; ++ai)
#pragma unroll
            for (int m = 0; m < 4; ++m) { const int row = row0 + ai * HALF + m * 16;
                const float rs = rsqrtf(rowss[row] * (1.0f / 256.0f) + eps_l);
                float inv = rs;
                if (isk) { float ss = 0.f;
#pragma unroll
                    for (int bj = 0; bj < 2; ++bj) ss += sum4sq(acc[ai][bj][m][0]) + sum4sq(acc[ai][bj][m][1]);
                    ss = red_fq(ss, fr, fq);
                    inv = rs * rsqrtf(rs * rs * ss * (1.0f / 64.0f) + eps_l); }
                bf16_t* rowp = obase + (size_t)row * 1024;
#pragma unroll
                for (int bj = 0; bj < 2; ++bj) { f32x4 a = acc[ai][bj][m][0] * inv, b = acc[ai][bj][m][1] * inv;
                    if (isk) { a = a * *(const f32x4*)(g_nope + 32 * bj + 8 * fq); b = b * *(const f32x4*)(g_nope + 32 * bj + 8 * fq + 4); }
                    *(u32x4*)(rowp + 32 * bj) = pack8(a, b); } }
    }
};
struct EpiDiff {
    static constexpr bool PERM = true, AFTER_DRAIN = false;
    bf16_t* O; const float* gq; const float* gk; const float* tab; float scale;
    __device__ __forceinline__ void operator()(const f32x4 (&acc)[2][2][4][2], const Unit& u, int wr, int wc, int fr, int fq) const {
        const int row0 = u.pm * BM + wr * 64 + fr;
        if (u.pn >= 8) {
#pragma unroll
            for (int ai = 0; ai < 2; ++ai)
#pragma unroll
                for (int m = 0; m < 4; ++m) { bf16_t* rowp = O + (size_t)(row0 + ai * HALF + m * 16) * 3072 + 2048 + (u.pn - 8) * 256 + wc * 64 + 8 * fq;
#pragma unroll
                    for (int bj = 0; bj < 2; ++bj) *(u32x4*)(rowp + 32 * bj) = pack8(acc[ai][bj][m][0], acc[ai][bj][m][1]); }
            return;
        }
        const bool isq = u.pn < 4; const int unit = 4 * (u.pn & 3) + wc; const float* gp = isq ? gq : gk; const float osc = isq ? scale : 1.0f;
        float eps_l = EPS_; asm volatile("" : "+v"(eps_l));
        const bool isctx = u.pm * BM >= ML_;
        f32x4 g[2][2];
#pragma unroll
        for (int bj = 0; bj < 2; ++bj)
#pragma unroll
            for (int n = 0; n < 2; ++n) g[bj][n] = *(const f32x4*)(gp + 32 * bj + 8 * fq + 4 * n);
#pragma unroll
        for (int ai = 0; ai < 2; ++ai)
#pragma unroll
            for (int m = 0; m < 4; ++m) { const int row = row0 + ai * HALF + m * 16;
                float ss = 0.f;
#pragma unroll
                for (int bj = 0; bj < 2; ++bj) ss += sum4sq(acc[ai][bj][m][0]) + sum4sq(acc[ai][bj][m][1]);
                ss = red_fq(ss, fr, fq);
                const float inv = rsqrtf(ss * (1.0f / 64.0f) + eps_l);
                const int t = row & 4095;
                bf16_t* rowp = O + (size_t)row * 3072 + (isq ? 0 : 1024) + unit * 64 + 8 * fq;
#pragma unroll
                for (int bj = 0; bj < 2; ++bj) { const int pos = bj ? (t & 63) : (t >> 6);
                    f32x4 y[2];
#pragma unroll
                    for (int n = 0; n < 2; ++n) { y[n] = acc[ai][bj][m][n] * inv * g[bj][n];
                        const f32x4 yp = shfl4x(y[n], fr, fq, 32);
                        if (!isctx) { const f32x4 cs = *(const f32x4*)(tab + pos * 16 + 8 * (fq & 1) + 4 * n), sn = *(const f32x4*)(tab + 1024 + pos * 16 + 8 * (fq & 1) + 4 * n);
                            y[n] = (fq >> 1) ? (y[n] * cs + yp * sn) : (y[n] * cs - yp * sn); }
                        y[n] = y[n] * osc; }
                    *(u32x4*)(rowp + 32 * bj) = pack8(y[0], y[1]); } }
    }
};
struct EpiStore {
    static constexpr bool PERM = true, AFTER_DRAIN = false;
    bf16_t* O; int ldo;
    __device__ __forceinline__ void operator()(const f32x4 (&acc)[2][2][4][2], const Unit& u, int wr, int wc, int fr, int fq) const {
        const int row0 = u.pm * BM + wr * 64 + fr;
#pragma unroll
        for (int ai = 0; ai < 2; ++ai)
#pragma unroll
            for (int m = 0; m < 4; ++m) { bf16_t* rowp = O + (size_t)(row0 + ai * HALF + m * 16) * ldo + u.pn * BM + wc * 32 + 8 * fq;
#pragma unroll
                for (int bj = 0; bj < 2; ++bj) *(u32x4*)(rowp + bj * HALF) = pack8(acc[ai][bj][m][0], acc[ai][bj][m][1]); }
    }
};

template <class Epi, class Sched, bool ALIGN_EPI = false, bool SP2 = false>
__device__ __forceinline__ void gemm_phase(PG8_LAS unsigned char* lds, const Gemm g, const Sched& S, const Epi& E) {
    int tid_o = threadIdx.x; asm volatile("" : "+v"(tid_o));
    const int tid = tid_o, wid = __builtin_amdgcn_readfirstlane(tid >> 6), lane = tid & 63, wr = wid >> 2, wc = wid & 3, fr = lane & 15, fq = lane >> 4;
    const int K = g.K, nt = K / BK;
    unsigned voffA[2], voffB[2];
#pragma unroll
    for (int i = 0; i < 2; ++i) { int R, C; stage_rc(tid * 16 + i * 8192, R, C); const int Rb = Epi::PERM ? ((R & ~31) + perm32(R & 31)) : R;
        voffA[i] = (unsigned)(R * g.lda + C) * 2u; voffB[i] = (unsigned)(Rb * K + C) * 2u; }
    const size_t kstep = (size_t)(BK * 2);
    const size_t hstep = (size_t)HALF * K * 2; const size_t hstepA = (size_t)HALF * g.lda * 2; const size_t tstepA = 2 * hstepA;
    const size_t tstep = 2 * hstep;
    const unsigned ldsw = (unsigned)wid * 1024u;
    const int aoff = lds_byte(wr * 64 + fr, fq * 8), boff = lds_byte(wc * 32 + fr, fq * 8);
#define PG8_SA(b, h) (((b) * 2 + (h)) * HTB)
#define PG8_SB(b, h) ((4 + (b) * 2 + (h)) * HTB)
#define PG8_STAGE(bufoff, gbase, voff) do { _Pragma("unroll") for (int _i = 0; _i < 2; ++_i) \
        __builtin_amdgcn_global_load_lds((const unsigned*)((const char*)(gbase) + (voff)[_i]), (PG8_LAS unsigned*)(lds + (bufoff) + ldsw + _i * 8192), 16, 0, 0); } while (0)
#define PG8_LDA(dst, b, h) do { _Pragma("unroll") for (int m = 0; m < 4; ++m) _Pragma("unroll") for (int k = 0; k < 2; ++k) dst[m][k] = *(const PG8_LAS bf16x8*)(lds + PG8_SA(b, h) + aoff + m * 2048 + k * 1024); } while (0)
#define PG8_LDB(dst, b, h) do { _Pragma("unroll") for (int n = 0; n < 2; ++n) _Pragma("unroll") for (int k = 0; k < 2; ++k) dst[n][k] = *(const PG8_LAS bf16x8*)(lds + PG8_SB(b, h) + boff + n * 2048 + k * 1024); } while (0)
#define PG8_MMA(ai, bj, At, Bt) do { __builtin_amdgcn_s_setprio(1); _Pragma("unroll") for (int m = 0; m < 4; ++m) _Pragma("unroll") for (int n = 0; n < 2; ++n) _Pragma("unroll") for (int k = 0; k < 2; ++k) \
        acc[ai][bj][m][n] = __builtin_amdgcn_mfma_f32_16x16x32_f16(__builtin_bit_cast(f16x8, Bt[n][k]), __builtin_bit_cast(f16x8, At[m][k]), acc[ai][bj][m][n], 0, 0, 0); __builtin_amdgcn_s_setprio(0); } while (0)
#define PG8_WAIT_V(n) asm volatile("s_waitcnt vmcnt(" #n ")" ::: "memory")
#define PG8_WAIT_L(n) asm volatile("s_waitcnt lgkmcnt(" #n ")" ::: "memory")
#define PG8_BAR __builtin_amdgcn_s_barrier()
#define PG8_SCHED __builtin_amdgcn_sched_barrier(0)
    Unit cur, nxt; int ui = 0;
    if (!S.next(0, cur)) return;
    f32x4 acc[2][2][4][2];
#pragma unroll
    for (int a = 0; a < 2; ++a)
#pragma unroll
        for (int b = 0; b < 2; ++b)
#pragma unroll
            for (int m = 0; m < 4; ++m)
#pragma unroll
                for (int n = 0; n < 2; ++n) acc[a][b][m][n] = (f32x4){0.f, 0.f, 0.f, 0.f};
    bf16x8 At[4][2], B0[2][2], B1[2][2];
    const char* cA = (const char*)g.A + (size_t)cur.pm * tstepA; const char* cB = (const char*)g.Bt + (size_t)cur.pn * tstep;
    S.a_ready(cur);
    if constexpr (SP2) {
        PG8_STAGE(PG8_SB(0, 0), cB, voffB); PG8_STAGE(PG8_SB(0, 1), cB + hstep, voffB); PG8_STAGE(PG8_SA(0, 0), cA, voffA); PG8_STAGE(PG8_SA(0, 1), cA + hstepA, voffA);
        if (wr == 1) PG8_BAR;
        PG8_WAIT_V(2); PG8_BAR;
        PG8_STAGE(PG8_SB(1, 0), cB + kstep, voffB); PG8_STAGE(PG8_SA(1, 0), cA + kstep, voffA); PG8_STAGE(PG8_SB(1, 1), cB + hstep + kstep, voffB);
        PG8_WAIT_V(6); PG8_BAR;
    } else {
        PG8_STAGE(PG8_SB(0, 0), cB, voffB); PG8_STAGE(PG8_SA(0, 0), cA, voffA); PG8_STAGE(PG8_SB(0, 1), cB + hstep, voffB); PG8_STAGE(PG8_SA(0, 1), cA + hstepA, voffA);
        if (wr == 1) PG8_BAR;
        PG8_WAIT_V(4); PG8_BAR;
        PG8_STAGE(PG8_SB(1, 0), cB + kstep, voffB); PG8_STAGE(PG8_SA(1, 0), cA + kstep, voffA); PG8_STAGE(PG8_SB(1, 1), cB + hstep + kstep, voffB);
        PG8_WAIT_V(6); PG8_BAR;
    }
    for (;;) {
        const bool has_next = S.next(ui + 1, nxt);
        const char* nA = has_next ? (const char*)g.A + (size_t)nxt.pm * tstepA : cA; const char* nB = has_next ? (const char*)g.Bt + (size_t)nxt.pn * tstep : cB;
        for (int t = 0; t < nt; t += 2) {
            const bool last = (t == nt - 2);
            const char* a1 = cA + (size_t)(t + 1) * kstep;
            const char* a2 = last ? nA : cA + (size_t)(t + 2) * kstep; const char* b2 = last ? nB : cB + (size_t)(t + 2) * kstep;
            const char* a3 = a2 + kstep; const char* b3 = b2 + kstep;
            if (last && has_next) S.a_ready(nxt);
            if constexpr (SP2) {
            PG8_LDB(B0, 0, 0); PG8_LDB(B1, 0, 1); PG8_SCHED; PG8_LDA(At, 0, 0); PG8_STAGE(PG8_SA(1, 1), a1 + hstepA, voffA);
            PG8_WAIT_V(8); PG8_WAIT_L(0); PG8_BAR; PG8_MMA(0, 0, At, B0); PG8_MMA(0, 1, At, B1); PG8_BAR; PG8_SCHED;
            PG8_LDA(At, 0, 1); PG8_STAGE(PG8_SB(0, 0), b2, voffB); PG8_STAGE(PG8_SB(0, 1), b2 + hstep, voffB); PG8_STAGE(PG8_SA(0, 0), a2, voffA);
            PG8_WAIT_V(8); PG8_WAIT_L(0); PG8_BAR; PG8_MMA(1, 0, At, B0); PG8_MMA(1, 1, At, B1); PG8_BAR; PG8_SCHED;
            PG8_LDB(B0, 1, 0); PG8_LDB(B1, 1, 1); PG8_SCHED; PG8_LDA(At, 1, 0); PG8_STAGE(PG8_SA(0, 1), a2 + hstepA, voffA);
            PG8_WAIT_V(8); PG8_WAIT_L(0); PG8_BAR; PG8_MMA(0, 0, At, B0); PG8_MMA(0, 1, At, B1); PG8_BAR; PG8_SCHED;
            PG8_LDA(At, 1, 1); PG8_STAGE(PG8_SB(1, 0), b3, voffB); PG8_STAGE(PG8_SB(1, 1), b3 + hstep, voffB); PG8_STAGE(PG8_SA(1, 0), a3, voffA);
            PG8_WAIT_V(8); PG8_WAIT_L(0); PG8_BAR; PG8_MMA(1, 0, At, B0); PG8_MMA(1, 1, At, B1); PG8_BAR; PG8_SCHED;
            } else {
            PG8_LDB(B0, 0, 0); PG8_SCHED; PG8_LDA(At, 0, 0); PG8_STAGE(PG8_SA(1, 1), a1 + hstepA, voffA);
            PG8_WAIT_L(8); PG8_BAR; PG8_WAIT_L(0); PG8_MMA(0, 0, At, B0); PG8_BAR; PG8_SCHED;
            PG8_LDB(B1, 0, 1); PG8_STAGE(PG8_SB(0, 0), b2, voffB);
            PG8_BAR; PG8_WAIT_L(0); PG8_MMA(0, 1, At, B1); PG8_BAR;
            PG8_LDA(At, 0, 1); PG8_STAGE(PG8_SA(0, 0), a2, voffA);
            PG8_BAR; PG8_WAIT_L(0); PG8_MMA(1, 0, At, B0); PG8_BAR; PG8_SCHED;
            PG8_STAGE(PG8_SB(0, 1), b2 + hstep, voffB);
            PG8_WAIT_V(6); PG8_BAR; PG8_MMA(1, 1, At, B1); PG8_BAR;
            PG8_LDB(B0, 1, 0); PG8_SCHED; PG8_LDA(At, 1, 0); PG8_STAGE(PG8_SA(0, 1), a2 + hstepA, voffA);
            PG8_WAIT_L(8); PG8_BAR; PG8_WAIT_L(0); PG8_MMA(0, 0, At, B0); PG8_BAR; PG8_SCHED;
            PG8_LDB(B1, 1, 1); PG8_STAGE(PG8_SB(1, 0), b3, voffB);
            PG8_BAR; PG8_WAIT_L(0); PG8_MMA(0, 1, At, B1); PG8_BAR;
            PG8_LDA(At, 1, 1); PG8_STAGE(PG8_SA(1, 0), a3, voffA);
            PG8_BAR; PG8_WAIT_L(0); PG8_MMA(1, 0, At, B0); PG8_BAR; PG8_SCHED;
            PG8_STAGE(PG8_SB(1, 1), b3 + hstep, voffB);
            PG8_WAIT_V(6); PG8_BAR; PG8_MMA(1, 1, At, B1); PG8_BAR;
            }
        }
        if constexpr (ALIGN_EPI) { if (wr == 0) PG8_BAR; }
        if constexpr (!Epi::AFTER_DRAIN) { int t2 = threadIdx.x; asm volatile("" : "+v"(t2)); const int fr2 = t2 & 15, fq2 = (t2 >> 4) & 3; E(acc, cur, wr, wc, fr2, fq2); S.done(cur); }
        if (!has_next) break;
#pragma unroll
        for (int a = 0; a < 2; ++a)
#pragma unroll
            for (int b = 0; b < 2; ++b)
#pragma unroll
                for (int m = 0; m < 4; ++m)
#pragma unroll
                    for (int n = 0; n < 2; ++n) acc[a][b][m][n] = (f32x4){0.f, 0.f, 0.f, 0.f};
        cur = nxt; cA = nA; cB = nB; ++ui;
        if constexpr (ALIGN_EPI) { if (wr == 1) PG8_BAR; }
    }
    PG8_WAIT_V(0);
    if constexpr (!ALIGN_EPI) { if (wr == 0) PG8_BAR; }
    PG8_BAR;
    if constexpr (Epi::AFTER_DRAIN) { E.fused(acc, cur, wr, wc, fr, fq, lds, wid, lane); S.done(cur); }
#undef PG8_SA
#undef PG8_SB
#undef PG8_STAGE
#undef PG8_LDA
#undef PG8_LDB
#undef PG8_MMA
#undef PG8_WAIT_V
#undef PG8_WAIT_L
#undef PG8_BAR
#undef PG8_SCHED
}
}
#define LAS __attribute__((address_space(3)))
typedef unsigned short bf16;
typedef unsigned v4u __attribute__((ext_vector_type(4)));
typedef unsigned v2u __attribute__((ext_vector_type(2)));
typedef float f32x4 __attribute__((ext_vector_type(4)));
typedef float f32x16 __attribute__((ext_vector_type(16)));
typedef short bf16x8 __attribute__((ext_vector_type(8)));
constexpr int D = 1024, NBATCH = 8, SEQ = 4096, CTXL = 256, FF = 2816;
constexpr int ML = NBATCH * SEQ, MC = NBATCH * CTXL, MT = ML + MC;
constexpr float EPS = 1e-6f;
constexpr float LOG2E = 1.4426950408889634f;
constexpr size_t MiB = 1u << 20;
constexpr size_t WS_ROWSS = 0;
constexpr size_t WS_TAB = 1 * MiB;
constexpr size_t WS_MOD = 2 * MiB;
constexpr size_t WS_HCTX = 4 * MiB;
constexpr size_t WS_W = 12 * MiB;
constexpr size_t W_IN = 0, W_B = 6 * MiB, W_C = 9 * MiB, W_OUT = 10 * MiB, W_GU = 12 * MiB, W_DN = 23 * MiB;
constexpr size_t WS_XN = 42 * MiB;
constexpr size_t WS_BIG = 110 * MiB;
constexpr size_t WS_KV = 314 * MiB;
constexpr size_t WS_KPE = 450 * MiB;
constexpr size_t WS_END = 454 * MiB;
constexpr size_t BIG_KVL = 52 * MiB, BIG_KPR = 70 * MiB;
constexpr size_t BIG_Q = 86 * MiB;
constexpr int LDS_BYTES = 147456;
#define XB_TMO      128
#define XB_XCNT(j)  (256  + 64 * (j))
#define XB_XSUB(j)  (1280 + 64 * (j))
#define XB_XGEN(j)  (2304 + 64 * (j))
#define XB_TOP      3328
#define XB_TOPGEN   3392
#define XCD_BAR_WORDS 3456
#define XB_SPIN_CAP (1u << 18)

__device__ __forceinline__ unsigned xb_ld(unsigned* p)              { return __hip_atomic_load(p, __ATOMIC_RELAXED, __HIP_MEMORY_SCOPE_AGENT); }
__device__ __forceinline__ unsigned xb_add(unsigned* p, unsigned v) { return __hip_atomic_fetch_add(p, v, __ATOMIC_RELAXED, __HIP_MEMORY_SCOPE_AGENT); }
__device__ __forceinline__ unsigned xb_xcc_id() { return (unsigned)__builtin_amdgcn_s_getreg((3 << 11) | 20) & 0xFu; }
#define XB_SPIN(cond, bar) do { unsigned _sp = 0; while (cond) { __builtin_amdgcn_s_sleep(1); \
    if ((++_sp & 255u) == 0u) { if (xb_ld(&(bar)[XB_TMO])) break; if (_sp > XB_SPIN_CAP) { atomicAdd(&(bar)[XB_TMO], 1u); break; } } } } while (0)

struct XcdBarrier {
    unsigned* bar; unsigned x;
    volatile LAS unsigned* st;
};

__device__ __forceinline__ XcdBarrier xcd_barrier_post(unsigned* bar, volatile LAS unsigned* st) {
    XcdBarrier b; b.bar = bar; b.x = xb_xcc_id(); b.st = st;
    if (threadIdx.x == 0) (void)xb_add(&bar[XB_XCNT(b.x)], 1u);
    return b;
}
__device__ __forceinline__ void xcd_barrier_complete(unsigned* bar, unsigned x, unsigned& nloc, unsigned& nx) {
    const unsigned G = gridDim.x * gridDim.y * gridDim.z;
    unsigned sum, cnt, mine, sp = 0u;
    for (;;) {
        sum = 0u; cnt = 0u; mine = 0u;
#pragma unroll
        for (unsigned j = 0; j < 16; ++j) { const unsigned c = xb_ld(&bar[XB_XCNT(j)]); sum += c; cnt += (c > 0u) ? 1u : 0u; mine = (j == x) ? c : mine; }
        if (sum == G) break;
        __builtin_amdgcn_s_sleep(1);
        if ((++sp & 255u) == 0u) { if (xb_ld(&bar[XB_TMO])) break; if (sp > XB_SPIN_CAP) { atomicAdd(&bar[XB_TMO], 1u); break; } }
    }
    nloc = mine > 0u ? mine : 1u; nx = cnt > 0u ? cnt : 1u;
}

__device__ __forceinline__ void xcd_barrier(const XcdBarrier& b) {
    asm volatile("s_waitcnt vmcnt(0)" ::: "memory");
    __syncthreads();
    if (threadIdx.x == 0) {
        unsigned* bar = b.bar;
        __builtin_amdgcn_s_waitcnt(0);
        unsigned nloc = b.st[0], nx = b.st[1];
        if (nloc == 0u) { xcd_barrier_complete(bar, b.x, nloc, nx); b.st[0] = nloc; b.st[1] = nx; }
        const unsigned old = xb_add(&bar[XB_XSUB(b.x)], 1u);
        const unsigned gen = old / nloc;
        if (old + 1u == (gen + 1u) * nloc) {
            __builtin_amdgcn_fence(__ATOMIC_RELEASE, "agent");
            asm volatile("s_waitcnt vmcnt(0)" ::: "memory");
            const unsigned og = xb_add(&bar[XB_TOP], 1u);
            const unsigned tg = og / nx;
            if (og + 1u == (tg + 1u) * nx) xb_add(&bar[XB_TOPGEN], 1u);
            else XB_SPIN(xb_ld(&bar[XB_TOPGEN]) == tg, bar);
            __builtin_amdgcn_fence(__ATOMIC_ACQUIRE, "agent");
            xb_add(&bar[XB_XGEN(b.x)], 1u);
            asm volatile("s_waitcnt vmcnt(0)" ::: "memory");
        } else {
            XB_SPIN(xb_ld(&bar[XB_XGEN(b.x)]) == gen, bar);
            __builtin_amdgcn_fence(__ATOMIC_ACQUIRE, "agent");
            asm volatile("s_waitcnt vmcnt(0)" ::: "memory");
        }
    }
    __syncthreads();
}

constexpr size_t WS_BAR = 3u << 20;
constexpr int BARGEN_OFF = 131072 + 512;
#define GRID_SYNC() xcd_barrier(xbar)
#define PHASE_IDS int t_o_ = threadIdx.x; asm volatile("" : "+v"(t_o_)); const int tid = t_o_, lane = tid & 63, wave = __builtin_amdgcn_readfirstlane(tid >> 6); const int gw = vcu * 8 + wave, gtid = bx * 512 + tid; (void)gw; (void)gtid; (void)lane; (void)wave;

struct Args { const float* in[34]; float* out; unsigned char* ws; };

__device__ __forceinline__ float wave_sum(float v) {
#pragma unroll
    for (int o = 1; o < 64; o <<= 1) v += __shfl_xor(v, o);
    return v;
}
__device__ __forceinline__ unsigned pk2(float lo, float hi) { return pg8::cvt_pk_bf16(lo, hi); }
__device__ __forceinline__ float bflo(unsigned w) { return (float)__builtin_bit_cast(pg8::f16x2, w)[0]; }
__device__ __forceinline__ float bfhi(unsigned w) { return (float)__builtin_bit_cast(pg8::f16x2, w)[1]; }


#ifdef DBG
#define DBG_OFF (WS_TAB + 65536)
#define DBG_SNAP (WS_TAB + 131072)
__device__ __forceinline__ void dbg_flag(unsigned char* ws, int bit) { atomicOr((unsigned*)(ws + DBG_OFF), 1u << bit); }
__device__ __forceinline__ bool dbg_bad(float got, float ref) { return !(fabsf(got - ref) <= 0.02f * fabsf(ref) + 0.02f); }
__device__ __forceinline__ unsigned hsh(unsigned x) { x ^= x >> 16; x *= 0x7feb352dU; x ^= x >> 15; x *= 0x846ca68bU; x ^= x >> 16; return x; }
__device__ __forceinline__ float h2f(const bf16* p) { return (float)*(const _Float16*)p; }
__device__ __forceinline__ float silu_x(float v) { return v / (1.0f + expf(-v)); }
#endif
enum { WK_IDENT = 0, WK_CONV_IN, WK_GU, WK_MLA_IN, WK_MLA_QUP, WK_MLA_KVUP, WK_PAIR64 };
__device__ __forceinline__ void conv_item(const float* W, int ldn, int K, int lcol, const float* gain, bf16* WT, int prow0, int k0, LAS float* scr, int lane) {
    if (lcol < 0) {
        const int c = lane & 7;
#pragma unroll
        for (int j = 0; j < 4; ++j) { const int n = (lane >> 3) + 8 * j; *(v4u*)(WT + (size_t)(prow0 + n) * K + k0 + 8 * c) = (v4u){0u, 0u, 0u, 0u}; }
        return;
    }
#pragma unroll 32
    for (int i = 0; i < 32; ++i) { const int kk = 2 * i + (lane >> 5); float v = W[(size_t)(k0 + kk) * ldn + lcol + (lane & 31)]; if (gain) v *= gain[k0 + kk]; scr[kk * 33 + (lane & 31)] = v; }
    asm volatile("s_waitcnt lgkmcnt(0)" ::: "memory");
    const int c = lane & 7;
#pragma unroll
    for (int j = 0; j < 4; ++j) { const int n = (lane >> 3) + 8 * j; const LAS float* s = scr + (8 * c) * 33 + n;
        v4u o; o.x = pk2(s[0 * 33], s[1 * 33]); o.y = pk2(s[2 * 33], s[3 * 33]); o.z = pk2(s[4 * 33], s[5 * 33]); o.w = pk2(s[6 * 33], s[7 * 33]);
        *(v4u*)(WT + (size_t)(prow0 + n) * K + k0 + 8 * c) = o; }
    asm volatile("s_waitcnt lgkmcnt(0)" ::: "memory");
}
__device__ __forceinline__ void conv_matrix_item(int kind, const float* s0, const float* s1, int ldn, int K, int Nphys, const float* gain, bf16* WT, int r, LAS float* scr, int lane) {
    const int ngr = Nphys / 32, kb = r / ngr, G = r % ngr; const int pn = G >> 3, bj = (G >> 2) & 1, wc = G & 3;
    const float* src = s0; int lcol = 32 * G;
    switch (kind) {
        case WK_CONV_IN: if (pn >= 4) lcol = (bj ? 2048 : 1024) + 128 * (pn - 4) + 32 * wc; break;
        case WK_GU: src = bj ? s1 : s0; lcol = 128 * pn + 32 * wc; break;
        case WK_MLA_IN: if (G >= 33) lcol = -1; break;
        case WK_MLA_QUP: lcol = pn < 4 ? (4 * pn + wc) * 96 + 32 * bj : (8 * (pn - 4) + 4 * bj + wc) * 96 + 64; break;
        case WK_MLA_KVUP: lcol = pn < 4 ? (4 * pn + wc) * 128 + 32 * bj : (4 * (pn - 4) + wc) * 128 + 64 + 32 * bj; break;
        case WK_PAIR64: lcol = 256 * pn + 64 * wc + 32 * bj; break;
        default: break;
    }
    conv_item(src, ldn, K, lcol, gain, WT, 32 * G, 64 * kb, scr, lane);
}
#define CONV_MAT(kind, s0, s1, ldn, K, Nphys, gain, dst) { const int ni_ = ((K) / 64) * ((Nphys) / 32); if (r < ni_) { conv_matrix_item(kind, s0, s1, ldn, K, Nphys, gain, dst, r, scr, lane); continue; } r -= ni_; }

template <int DQK, int DV, bool SPLIT> struct AttnP {
    const bf16* Q; int ldq;
    const bf16* K; int ldk;
    const bf16* Kpe;
    const bf16* V; int ldv;
    bf16* O;
    float lam, fin;
    const float* subg;
};
template <int DQK, int DV, bool SPLIT>
__device__ __forceinline__ void attn_unit(LAS unsigned char* lds, const AttnP<DQK, DV, SPLIT>& P, int b, int h, int qrow0, int ntiles_in) {
    constexpr int KW = SPLIT ? 128 : DQK;
    constexpr int KSTR = KW * 2 + 16, VSTR = 144;
    constexpr int KT = 64 * KSTR, VT = DV * VSTR, BUF = KT + VT;
    constexpr int NQ = DQK / 16, NDV = DV / 32;
    constexpr int NKC = SPLIT ? 2 : 1, NVC = DV / 64;
    int tid_o = threadIdx.x; asm volatile("" : "+v"(tid_o));
    const int tid = tid_o, lane = tid & 63, w = __builtin_amdgcn_readfirstlane(tid >> 6), l32 = lane & 31, hh = lane >> 5;
    const int stream = SPLIT ? (w >> 2) : 0;
    const int qrow = qrow0 + 32 * (SPLIT ? (w & 3) : w) + l32;
    int ntiles = ntiles_in; asm volatile("" : "+s"(ntiles));
    const int ctx0 = ML + b * CTXL, lat0 = b * SEQ;
    bf16x8 qf[NQ];
    { const bf16* qp = P.Q + (size_t)qrow * P.ldq + (SPLIT ? h * 128 + 64 * stream : h * DQK) + 8 * hh;
#pragma unroll
      for (int s = 0; s < NQ; ++s) qf[s] = *(const bf16x8*)(qp + 16 * s); }
    f32x16 o[NDV];
#pragma unroll
    for (int i = 0; i < NDV; ++i)
#pragma unroll
        for (int r = 0; r < 16; ++r) o[i][r] = 0.f;
    f32x16 negm;
    if constexpr (!SPLIT) {
#pragma unroll
    for (int r = 0; r < 16; ++r) negm[r] = -2.0f;
    } else {
#pragma unroll
    for (int r = 0; r < 16; ++r) negm[r] = 0.f;
    asm volatile("" : "+v"(negm));
    }
    float mrun = 0.f, lrun = 0.f;
    v4u kreg[2][NKC]; v4u kpreg[2]; v2u va[2][NVC], vb[2][NVC];
    const int vpr = tid & 31, vc4 = tid >> 5;
    const int vkey = ((2 * vpr) & ~12) | (((2 * vpr) >> 2) & 1) << 3 | (((2 * vpr) >> 3) & 1) << 2;
#define ATT_ROW0(t) (64 * (t) + (((t) < 4) ? ctx0 : lat0 - 256))
#define ATT_LOADK(t, S_) do { const int kr0_ = ATT_ROW0(t); \
        if (SPLIT) { _Pragma("unroll") for (int i_ = 0; i_ < NKC; ++i_) { const int idx_ = tid + 512 * i_; kreg[S_][i_] = *(const v4u*)(P.K + (size_t)(kr0_ + (idx_ >> 4)) * P.ldk + h * 128 + (idx_ & 15) * 8); } } \
        else { kreg[S_][0] = *(const v4u*)(P.K + (size_t)(kr0_ + (tid >> 3)) * P.ldk + h * 64 + (tid & 7) * 8); kpreg[S_] = *(const v4u*)(P.Kpe + (size_t)(kr0_ + ((tid & 255) >> 2)) * 32 + (tid & 3) * 8); } } while (0)
#define ATT_LOADV(t, S_) do { const int kr0_ = ATT_ROW0(t); \
        _Pragma("unroll") for (int i_ = 0; i_ < NVC; ++i_) { const bf16* vp_ = P.V + (size_t)(kr0_ + vkey) * P.ldv + h * DV + 4 * (vc4 + 16 * i_); va[S_][i_] = *(const v2u*)vp_; vb[S_][i_] = *(const v2u*)(vp_ + P.ldv); } } while (0)
#define ATT_STOREK(buf, S_) do { LAS unsigned char* kb_ = lds + (buf) * KT; \
        if (SPLIT) { _Pragma("unroll") for (int i_ = 0; i_ < NKC; ++i_) { const int idx_ = tid + 512 * i_; *(LAS v4u*)(kb_ + (idx_ >> 4) * KSTR + (idx_ & 15) * 16) = kreg[S_][i_]; } } \
        else { *(LAS v4u*)(kb_ + (tid >> 3) * KSTR + (tid & 7) * 16) = kreg[S_][0]; *(LAS v4u*)(kb_ + ((tid & 255) >> 2) * KSTR + 128 + (tid & 3) * 16) = kpreg[S_]; } } while (0)
#define ATT_STOREV(buf, S_) do { LAS unsigned char* vb_ = lds + 2 * KT + (buf) * VT; \
        _Pragma("unroll") for (int i_ = 0; i_ < NVC; ++i_) { LAS unsigned char* d_ = vb_ + (4 * (vc4 + 16 * i_)) * VSTR + vpr * 4; \
            *(LAS unsigned*)(d_) = (va[S_][i_].x & 0xffffu) | (vb[S_][i_].x << 16); *(LAS unsigned*)(d_ + VSTR) = (va[S_][i_].x >> 16) | (vb[S_][i_].x & 0xffff0000u); \
            *(LAS unsigned*)(d_ + 2 * VSTR) = (va[S_][i_].y & 0xffffu) | (vb[S_][i_].y << 16); *(LAS unsigned*)(d_ + 3 * VSTR) = (va[S_][i_].y >> 16) | (vb[S_][i_].y & 0xffff0000u); } } while (0)
#define ATT_QK(dst, buf) do { const LAS unsigned char* kb_ = lds + (buf) * KT; bf16x8 kf_[2][NQ]; \
        _Pragma("unroll") for (int kk = 0; kk < 2; ++kk) { const LAS unsigned char* kp = kb_ + (32 * kk + l32) * KSTR + (SPLIT ? 128 * stream : 0) + 16 * hh; \
            _Pragma("unroll") for (int q = 0; q < NQ; ++q) kf_[kk][q] = *(const LAS bf16x8*)(kp + 32 * q); } \
        __builtin_amdgcn_sched_barrier(0);     \
        _Pragma("unroll") for (int kk = 0; kk < 2; ++kk) dst[kk] = __builtin_amdgcn_mfma_f32_32x32x16_f16(__builtin_bit_cast(pg8::f16x8, kf_[kk][0]), __builtin_bit_cast(pg8::f16x8, qf[0]), negm, 0, 0, 0); \
        _Pragma("unroll") for (int q = 1; q < NQ; ++q) { _Pragma("unroll") for (int kk = 0; kk < 2; ++kk) \
            dst[kk] = __builtin_amdgcn_mfma_f32_32x32x16_f16(__builtin_bit_cast(pg8::f16x8, kf_[kk][q]), __builtin_bit_cast(pg8::f16x8, qf[q]), dst[kk], 0, 0, 0); } \
        __builtin_amdgcn_sched_barrier(0); } while (0)
    constexpr float THR = 6.0f;
    f32x16 s[2];
    ATT_LOADK(0, 0); ATT_LOADV(0, 0); ATT_LOADK(1, 1); ATT_LOADV(1, 1);
    ATT_STOREK(0, 0); ATT_STOREV(0, 0);
    asm volatile("s_waitcnt lgkmcnt(0)\n\ts_barrier" ::: "memory");
    if (w >= 4) asm volatile("s_barrier" ::: "memory");
    for (int t0 = 0; t0 < ntiles; t0 += 2) {
#pragma unroll
      for (int u2 = 0; u2 < 2; ++u2) {
        const int t = t0 + u2;
        { const int tl_ = (t + 2 < ntiles) ? t + 2 : ntiles - 1; ATT_LOADK(tl_, u2); ATT_LOADV(tl_, u2); }
        ATT_QK(s, u2);
        if constexpr (SPLIT) {
        float mxa = __builtin_fmaxf(__builtin_fmaxf(s[0][0], s[0][1]), s[1][0]), mxb = __builtin_fmaxf(__builtin_fmaxf(s[0][2], s[0][3]), s[1][1]); mxa = __builtin_fmaxf(__builtin_fmaxf(mxa, s[1][2]), s[1][3]);
#pragma unroll
        for (int r = 4; r < 16; r += 4) { mxa = __builtin_fmaxf(__builtin_fmaxf(mxa, s[0][r]), s[0][r + 1]); mxb = __builtin_fmaxf(__builtin_fmaxf(mxb, s[0][r + 2]), s[0][r + 3]);
            mxa = __builtin_fmaxf(__builtin_fmaxf(mxa, s[1][r]), s[1][r + 1]); mxb = __builtin_fmaxf(__builtin_fmaxf(mxb, s[1][r + 2]), s[1][r + 3]); }
        float mx = __builtin_fmaxf(mxa, mxb);
        mx = fmaxf(mx, pg8::lanex(mx, lane, 32));
        if (t == 0 || __any(mx > THR)) {
            const float delta = (t == 0) ? mx : fmaxf(mx, 0.f); const float alpha = (t == 0) ? 0.f : __builtin_amdgcn_exp2f(-delta); mrun += delta; lrun *= alpha;
#pragma unroll
            for (int i = 0; i < NDV; ++i)
#pragma unroll
                for (int r = 0; r < 16; ++r) o[i][r] *= alpha;
#pragma unroll
            for (int kk = 0; kk < 2; ++kk)
#pragma unroll
                for (int r = 0; r < 16; ++r) s[kk][r] -= delta;
#pragma unroll
            for (int r = 0; r < 16; ++r) negm[r] = -mrun;
            asm volatile("" : "+v"(negm));
        }
        }
        ATT_STOREK((u2 ^ 1), (u2 ^ 1));
        asm volatile("s_waitcnt lgkmcnt(0)\n\ts_barrier" ::: "memory");
        float ps = 0.f, ps2 = 0.f;
#pragma unroll
        for (int kk = 0; kk < 2; ++kk)
#pragma unroll
            for (int r = 0; r < 16; r += 2) { s[kk][r] = __builtin_amdgcn_exp2f(s[kk][r]); s[kk][r + 1] = __builtin_amdgcn_exp2f(s[kk][r + 1]); ps += s[kk][r]; ps2 += s[kk][r + 1]; }
        lrun += ps + ps2;
        bf16x8 pf[2][2];
#pragma unroll
        for (int kk = 0; kk < 2; ++kk)
#pragma unroll
            for (int ss = 0; ss < 2; ++ss) { v4u wv; wv.x = pg8::cvt_pk_bf16(s[kk][8 * ss + 0], s[kk][8 * ss + 1]); wv.y = pg8::cvt_pk_bf16(s[kk][8 * ss + 2], s[kk][8 * ss + 3]);
                wv.z = pg8::cvt_pk_bf16(s[kk][8 * ss + 4], s[kk][8 * ss + 5]); wv.w = pg8::cvt_pk_bf16(s[kk][8 * ss + 6], s[kk][8 * ss + 7]); pf[kk][ss] = __builtin_bit_cast(bf16x8, wv); }
        { const LAS unsigned char* vbp = lds + 2 * KT + u2 * VT;
#pragma unroll
          for (int i = 0; i < NDV; i += 2) {
            bf16x8 vf[2][4];
#pragma unroll
            for (int j = 0; j < 2; ++j) { const LAS unsigned char* vp = vbp + (32 * (i + j) + l32) * VSTR + 16 * hh;
#pragma unroll
                for (int c = 0; c < 4; ++c) vf[j][c] = *(const LAS bf16x8*)(vp + 32 * c); }
            __builtin_amdgcn_sched_barrier(0);
#pragma unroll
            for (int c = 0; c < 4; ++c)
#pragma unroll
                for (int j = 0; j < 2; ++j) o[i + j] = __builtin_amdgcn_mfma_f32_32x32x16_f16(__builtin_bit_cast(pg8::f16x8, vf[j][c]), __builtin_bit_cast(pg8::f16x8, pf[c >> 1][c & 1]), o[i + j], 0, 0, 0);
            __builtin_amdgcn_sched_barrier(0);
          } }
        ATT_STOREV((u2 ^ 1), (u2 ^ 1));
        asm volatile("s_waitcnt lgkmcnt(0)\n\ts_barrier" ::: "memory");
      }
    }
    if (w < 4) asm volatile("s_barrier" ::: "memory");
#undef ATT_ROW0
#undef ATT_LOADK
#undef ATT_LOADV
#undef ATT_STOREK
#undef ATT_STOREV
#undef ATT_QK
    const float ltot = lrun + pg8::lanex(lrun, lane, 32);
    const float linv = 1.0f / ltot;
    if (!SPLIT) {
        bf16* op = P.O + (size_t)qrow * 1024 + h * DV + 4 * hh;
#pragma unroll
        for (int i = 0; i < NDV; ++i)
#pragma unroll
            for (int g = 0; g < 4; ++g) { v2u wv; wv.x = pg8::cvt_pk_bf16(o[i][4 * g] * linv, o[i][4 * g + 1] * linv); wv.y = pg8::cvt_pk_bf16(o[i][4 * g + 2] * linv, o[i][4 * g + 3] * linv);
                *(v2u*)(op + 32 * i + 8 * g) = wv; }
    } else {
        LAS f32x4* X = (LAS f32x4*)lds;
        if (w >= 4) {
#pragma unroll
            for (int i = 0; i < NDV; ++i)
#pragma unroll
                for (int g = 0; g < 4; ++g) X[(((w & 3) * 16 + i * 4 + g) * 64) + lane] = (f32x4){o[i][4 * g] * linv, o[i][4 * g + 1] * linv, o[i][4 * g + 2] * linv, o[i][4 * g + 3] * linv};
        }
        __syncthreads();
        if (w < 4) {
            float ss = 0.f;
#pragma unroll
            for (int i = 0; i < NDV; ++i)
#pragma unroll
                for (int g = 0; g < 4; ++g) { const f32x4 x2 = X[((w * 16 + i * 4 + g) * 64) + lane];
#pragma unroll
                    for (int e = 0; e < 4; ++e) { const float c = o[i][4 * g + e] * linv - P.lam * x2[e]; o[i][4 * g + e] = c; ss += c * c; } }
            ss += pg8::lanex(ss, lane, 32);
            const float rn = rsqrtf(ss * (1.0f / 128.0f) + EPS) * P.fin;
            bf16* op = P.O + (size_t)qrow * 1024 + h * DV + 4 * hh;
#pragma unroll
            for (int i = 0; i < NDV; ++i)
#pragma unroll
                for (int g = 0; g < 4; ++g) { const f32x4 gg = *(const f32x4*)(P.subg + 32 * i + 8 * g + 4 * hh);
                    v2u wv; wv.x = pg8::cvt_pk_bf16(o[i][4 * g] * rn * gg[0], o[i][4 * g + 1] * rn * gg[1]); wv.y = pg8::cvt_pk_bf16(o[i][4 * g + 2] * rn * gg[2], o[i][4 * g + 3] * rn * gg[3]);
                    *(v2u*)(op + 32 * i + 8 * g) = wv; }
        }
        __syncthreads();
    }
}

constexpr int PTAB_OFF = 131072 + 1024;
enum { I_X = 0, I_C, I_CTX, I_CCTX, I_NMG, I_NFG, I_MODW, I_MODB, I_FWG, I_FWU, I_FWD, I_CWIN, I_CK, I_CB, I_CWOUT, I_MWIN, I_MQNG, I_MWQUP, I_MKVNG, I_MWKVUP,
       I_MQNN, I_MQNR, I_MKNN, I_MKNR, I_MWOUT, I_DWIN, I_DQNG, I_DKNG, I_DLQ1, I_DLK1, I_DLQ2, I_DLK2, I_DSUBG, I_DWOUT, I_OUT, I_WS };
typedef __attribute__((address_space(4))) const unsigned long long* kptr_t;
__device__ __forceinline__ unsigned long long ptab_get(LAS unsigned char* lds, int i) {
    (void)lds; kptr_t ka = (kptr_t)__builtin_amdgcn_kernarg_segment_ptr(); asm volatile("" : "+s"(ka)); return ka[i];
}
#define GASP __attribute__((address_space(1)))
#define PF(i) ((const float*)(GASP const float*)ptab_get(lds, (i)))
#define PWS() ((unsigned char*)(GASP unsigned char*)ptab_get(lds, I_WS))
#define POUT() ((float*)(GASP float*)ptab_get(lds, I_OUT))

#ifndef KNOCK
#define KNOCK 0
#endif
#define GEMM_PHASE(ID_, EpiT, Aptr, lda_, Bptr, Mrows, Ncols, Kdim, ...) do { if constexpr (!((KNOCK >> (ID_)) & 1)) { pg8::Gemm g_{(const pg8::bf16_t*)(Aptr), (const pg8::bf16_t*)(Bptr), (Mrows), (Ncols), (Kdim), (lda_)}; pg8::StaticOrder S_; S_.init((Mrows), (Ncols), G, ((ID_) == 3 ? (bx + 192) % G : bx)); \
        EpiT E_{__VA_ARGS__}; pg8::gemm_phase<EpiT, pg8::StaticOrder, true, true>(lds, g_, S_, E_); } } while (0)
#define WSP(T, off) ((T*)(PWS() + (off)))
#define NORM_ROWS(hl, hc, gvec, shoff, scoff, Mr) do { PHASE_IDS const float* hl_ = (hl); const float* hc_ = (hc); const float* gv_ = (gvec); const float* modL_ = WSP(float, WS_MOD) + (size_t)L * 9 * 6144; bf16* XN_ = WSP(bf16, WS_XN); \
            for (int row0_ = gw; row0_ < (Mr); row0_ += 2 * NGW) { const int row1_ = row0_ + NGW; const bool has1_ = row1_ < (Mr); const int rowb_ = has1_ ? row1_ : row0_;     \
                const bool isc0 = row0_ >= ML, isc1 = rowb_ >= ML; const float* hr0 = isc0 ? hc_ + (size_t)(row0_ - ML) * D : hl_ + (size_t)row0_ * D; const float* hr1 = isc1 ? hc_ + (size_t)(rowb_ - ML) * D : hl_ + (size_t)rowb_ * D; \
                const f32x4* xr0 = (const f32x4*)hr0 + lane; const f32x4* xr1 = (const f32x4*)hr1 + lane; f32x4 v0[4], v1[4]; float s0 = 0.f, s1 = 0.f; \
                _Pragma("unroll") for (int j = 0; j < 4; ++j) { v0[j] = xr0[64 * j]; v1[j] = xr1[64 * j]; } \
                _Pragma("unroll") for (int j = 0; j < 4; ++j) { s0 += (v0[j].x * v0[j].x + v0[j].y * v0[j].y) + (v0[j].z * v0[j].z + v0[j].w * v0[j].w); s1 += (v1[j].x * v1[j].x + v1[j].y * v1[j].y) + (v1[j].z * v1[j].z + v1[j].w * v1[j].w); } \
                _Pragma("unroll") for (int o_ = 1; o_ < 64; o_ <<= 1) { s0 += __shfl_xor(s0, o_); s1 += __shfl_xor(s1, o_); } \
                const float rstd0 = rsqrtf(s0 * (1.0f / D) + EPS), rstd1 = rsqrtf(s1 * (1.0f / D) + EPS); const int mi0 = isc0 ? 8 : (row0_ >> 12), mi1 = isc1 ? 8 : (rowb_ >> 12); \
                const f32x4* gr = (const f32x4*)gv_ + lane; \
                const f32x4* sh0 = (const f32x4*)(modL_ + mi0 * 6144 + (shoff)) + lane; const f32x4* sc0 = (const f32x4*)(modL_ + mi0 * 6144 + (scoff)) + lane; \
                const f32x4* sh1 = (const f32x4*)(modL_ + mi1 * 6144 + (shoff)) + lane; const f32x4* sc1 = (const f32x4*)(modL_ + mi1 * 6144 + (scoff)) + lane; \
                unsigned long long* o80 = (unsigned long long*)(XN_ + (size_t)row0_ * D) + lane; unsigned long long* o81 = (unsigned long long*)(XN_ + (size_t)rowb_ * D) + lane; \
                _Pragma("unroll") for (int j = 0; j < 4; ++j) { const f32x4 gg = gr[64 * j]; const f32x4 y0 = v0[j] * rstd0 * gg * (sc0[64 * j] + 1.0f) + sh0[64 * j]; \
                    o80[64 * j] = (unsigned long long)pk2(y0.x, y0.y) | ((unsigned long long)pk2(y0.z, y0.w) << 32); \
                    if (has1_) { const f32x4 y1 = v1[j] * rstd1 * gg * (sc1[64 * j] + 1.0f) + sh1[64 * j]; o81[64 * j] = (unsigned long long)pk2(y1.x, y1.y) | ((unsigned long long)pk2(y1.z, y1.w) << 32); } } } } while (0)
template <int LL, int PART, int SKIP = 0> __device__ __forceinline__ void convert_weights(LAS unsigned char* lds, const int G, const int bx, const int vcu) {
    constexpr int kind = LL % 3, slot = LL / 3; const int NGW = (G - SKIP) * 8;
    if (bx < SKIP) return;
    PHASE_IDS
    unsigned char* ws = PWS();
    bf16* W_in = (bf16*)(ws + WS_W + W_IN); bf16* W_b = (bf16*)(ws + WS_W + W_B); bf16* W_c = (bf16*)(ws + WS_W + W_C); bf16* W_out = (bf16*)(ws + WS_W + W_OUT); bf16* W_gu = (bf16*)(ws + WS_W + W_GU); bf16* W_dn = (bf16*)(ws + WS_W + W_DN);
    (void)W_b; (void)W_c;
    LAS float* scr = (LAS float*)(lds + wave * 16384);
    const float* fg = PF(I_FWG) + (size_t)LL * D * FF; const float* fu = PF(I_FWU) + (size_t)LL * D * FF; const float* fd = PF(I_FWD) + (size_t)LL * FF * D;
    int total = 0;
    if (PART != 2) { total += (D / 64) * (2 * FF / 32);
        if (kind == 0) total += (D / 64) * (3072 / 32) + (D / 64) * (D / 32);
        else if (kind == 1) total += (D / 64) * (1280 / 32) + (768 / 64) * (1536 / 32) + (256 / 64) * (2048 / 32) + (D / 64) * (D / 32);
        else total += (D / 64) * (3072 / 32) + (D / 64) * (D / 32); }
    if (PART != 1) total += (FF / 64) * (D / 32);
    for (int it = (bx - SKIP) * 8 + wave; it < total; it += NGW) {
        int r = it;
        if (PART != 1) { CONV_MAT(WK_IDENT, fd, fd, D, FF, D, nullptr, W_dn) }
        if (PART != 2) {
            CONV_MAT(WK_GU, fg, fu, FF, D, 2 * FF, nullptr, W_gu)
            if (kind == 0) {
                CONV_MAT(WK_CONV_IN, PF(I_CWIN) + (size_t)slot * D * 3072, nullptr, 3072, D, 3072, nullptr, W_in)
                CONV_MAT(WK_IDENT, PF(I_CWOUT) + (size_t)slot * D * D, nullptr, D, D, D, nullptr, W_out)
            } else if (kind == 1) {
                CONV_MAT(WK_MLA_IN, PF(I_MWIN), nullptr, 1056, D, 1280, nullptr, W_in)
                CONV_MAT(WK_MLA_QUP, PF(I_MWQUP), nullptr, 1536, 768, 1536, PF(I_MQNG), W_b)
                CONV_MAT(WK_MLA_KVUP, PF(I_MWKVUP), nullptr, 2048, 256, 2048, PF(I_MKVNG), W_c)
                CONV_MAT(WK_IDENT, PF(I_MWOUT), nullptr, D, D, D, nullptr, W_out)
            } else {
                CONV_MAT(WK_PAIR64, PF(I_DWIN), nullptr, 3072, D, 3072, nullptr, W_in)
                CONV_MAT(WK_IDENT, PF(I_DWOUT), nullptr, D, D, D, nullptr, W_out)
            }
        }
    }
}
template <int L> __device__ __forceinline__ void layer_fn(LAS unsigned char* lds, const int G, const int bx, const int vcu, const XcdBarrier& xbar) {
    const int NGW = G * 8, GS = G * 512;
    {
        constexpr int kind = L % 3, slot = L / 3; constexpr bool last = (L == 3);
        constexpr int Mrows = last ? ML : MT;
        constexpr int Mffn = (L >= 2) ? ML : MT;
        if constexpr (L > 0) convert_weights<L, 2>(lds, G, bx, vcu);
        NORM_ROWS((L == 0) ? PF(I_X) : (const float*)POUT(), (L == 0) ? PF(I_CTX) : WSP(const float, WS_HCTX), PF(I_NMG) + L * D, 0, 1024, Mrows);
        GRID_SYNC();
#ifdef DBG
        if constexpr (L == 0) { PHASE_IDS unsigned char* ws = PWS(); const unsigned sidx = (unsigned)gtid;
            { const int l = sidx & 3, j = (sidx >> 2) % 9, n = hsh(sidx) % 6144; const float* cv = j < 8 ? PF(I_C) + j * 1024 : PF(I_CCTX); const float* mw = PF(I_MODW) + (size_t)l * 1024 * 6144 + n;
              float ref = PF(I_MODB)[l * 6144 + n]; for (int k = 0; k < 1024; ++k) ref += silu_x(cv[k]) * mw[(size_t)k * 6144];
              if (dbg_bad(WSP(float, WS_MOD)[(size_t)(l * 9 + j) * 6144 + n], ref)) dbg_flag(ws, 0); }
            { const int row = hsh(sidx + 11u) % MT, col = hsh(sidx + 7777u) % 1024; const bool isc = row >= ML; const float* hr = isc ? PF(I_CTX) + (size_t)(row - ML) * D : PF(I_X) + (size_t)row * D; const int mi = isc ? 8 : (row >> 12);
              float ss = 0.f; for (int k = 0; k < 1024; ++k) ss += hr[k] * hr[k]; const float rstd = 1.0f / sqrtf(ss / 1024.0f + 1e-6f); const float* md = WSP(float, WS_MOD) + mi * 6144;
              const float ref = hr[col] * rstd * PF(I_NMG)[col] * (1.0f + md[1024 + col]) + md[col];
              if (dbg_bad(h2f(WSP(bf16, WS_XN) + (size_t)row * D + col), ref)) dbg_flag(ws, 1); } }
        GRID_SYNC();
#endif
        if constexpr (kind == 0) {
            GEMM_PHASE(0, pg8::EpiPair<0>, WSP(bf16, WS_XN), D, WSP(bf16, WS_W + W_IN), Mrows, 3072, D, WSP(bf16, WS_BIG));
            GRID_SYNC();
#ifdef DBG
            if constexpr (L == 0) { PHASE_IDS unsigned char* ws = PWS(); const unsigned sidx = (unsigned)gtid; const int row = hsh(sidx + 5u) % MT, col = hsh(sidx * 3u + 1u) % 1024;
                const bf16* xr = WSP(bf16, WS_XN) + (size_t)row * D; const float* w = PF(I_CWIN) + col; float b = 0.f, c = 0.f, u = 0.f;
                for (int k = 0; k < 1024; ++k) { const float a = h2f(xr + k); b += a * w[(size_t)k * 3072]; c += a * w[(size_t)k * 3072 + 1024]; u += a * w[(size_t)k * 3072 + 2048]; }
                const bf16* pr = WSP(bf16, WS_BIG) + (size_t)row * 2048;
                if (dbg_bad(h2f(pr + col), b) || dbg_bad(h2f(pr + 1024 + col), c * u)) dbg_flag(ws, 2); }
        GRID_SYNC();
#endif
            { PHASE_IDS const float* ck = PF(I_CK) + (size_t)slot * 3 * D; const float* cb = PF(I_CB) + (size_t)slot * D; const bf16* BIG = WSP(bf16, WS_BIG); bf16* XN = WSP(bf16, WS_XN);
              for (int idx = gtid; idx < Mrows * 128; idx += GS) { const int row = idx >> 7, c8 = (idx & 127) * 8;
                  const bool isc = row >= ML; const int t = isc ? ((row - ML) & 255) : (row & 4095); const int tmax = isc ? 255 : 4095;
                  const bf16* pr = BIG + (size_t)row * 2048 + c8;
                  const v4u bb = *(const v4u*)pr; const v4u z0 = *(const v4u*)(pr + 1024);
                  v4u zm = (v4u){0u, 0u, 0u, 0u}, zp = zm; if (t > 0) zm = *(const v4u*)(pr + 1024 - 2048); if (t < tmax) zp = *(const v4u*)(pr + 1024 + 2048);
                  const f32x4 k0a = *(const f32x4*)(ck + c8), k0b = *(const f32x4*)(ck + c8 + 4), k1a = *(const f32x4*)(ck + D + c8), k1b = *(const f32x4*)(ck + D + c8 + 4), k2a = *(const f32x4*)(ck + 2 * D + c8), k2b = *(const f32x4*)(ck + 2 * D + c8 + 4);
                  const f32x4 cba = *(const f32x4*)(cb + c8), cbb = *(const f32x4*)(cb + c8 + 4);
                  v4u ov;
                  { float y0, y1;
                    y0 = bflo(bb.x) * (k0a[0] * bflo(zm.x) + k1a[0] * bflo(z0.x) + k2a[0] * bflo(zp.x) + cba[0]); y1 = bfhi(bb.x) * (k0a[1] * bfhi(zm.x) + k1a[1] * bfhi(z0.x) + k2a[1] * bfhi(zp.x) + cba[1]); ov.x = pk2(y0, y1);
                    y0 = bflo(bb.y) * (k0a[2] * bflo(zm.y) + k1a[2] * bflo(z0.y) + k2a[2] * bflo(zp.y) + cba[2]); y1 = bfhi(bb.y) * (k0a[3] * bfhi(zm.y) + k1a[3] * bfhi(z0.y) + k2a[3] * bfhi(zp.y) + cba[3]); ov.y = pk2(y0, y1);
                    y0 = bflo(bb.z) * (k0b[0] * bflo(zm.z) + k1b[0] * bflo(z0.z) + k2b[0] * bflo(zp.z) + cbb[0]); y1 = bfhi(bb.z) * (k0b[1] * bfhi(zm.z) + k1b[1] * bfhi(z0.z) + k2b[1] * bfhi(zp.z) + cbb[1]); ov.z = pk2(y0, y1);
                    y0 = bflo(bb.w) * (k0b[2] * bflo(zm.w) + k1b[2] * bflo(z0.w) + k2b[2] * bflo(zp.w) + cbb[2]); y1 = bfhi(bb.w) * (k0b[3] * bfhi(zm.w) + k1b[3] * bfhi(z0.w) + k2b[3] * bfhi(zp.w) + cbb[3]); ov.w = pk2(y0, y1); }
                  *(v4u*)(XN + (size_t)row * D + c8) = ov; } }
            GRID_SYNC();
#ifdef DBG
            if constexpr (L == 0) { PHASE_IDS unsigned char* ws = PWS(); const unsigned sidx = (unsigned)gtid; const int row = hsh(sidx + 9u) % MT, col = hsh(sidx * 5u + 2u) % 1024;
                const bool isc = row >= ML; const int t = isc ? ((row - ML) & 255) : (row & 4095); const int tmax = isc ? 255 : 4095; const bf16* pr = WSP(bf16, WS_BIG) + (size_t)row * 2048;
                const float* ck = PF(I_CK); float y = PF(I_CB)[col] + ck[D + col] * h2f(pr + 1024 + col); if (t > 0) y += ck[col] * h2f(pr - 2048 + 1024 + col); if (t < tmax) y += ck[2 * D + col] * h2f(pr + 2048 + 1024 + col);
                if (dbg_bad(h2f(WSP(bf16, WS_XN) + (size_t)row * D + col), h2f(pr + col) * y)) dbg_flag(ws, 3); }
        GRID_SYNC();
#endif
        } else if constexpr (kind == 1) {
            GEMM_PHASE(1, pg8::EpiMlaIn, WSP(bf16, WS_XN), D, WSP(bf16, WS_W + W_IN), MT, 1280, D, WSP(bf16, WS_BIG), WSP(bf16, WS_BIG + BIG_KVL), WSP(bf16, WS_BIG + BIG_KPR), WSP(float, WS_ROWSS));
            GRID_SYNC();
            GEMM_PHASE(2, pg8::EpiMlaQ, WSP(bf16, WS_BIG), 768, WSP(bf16, WS_W + W_B), MT, 1536, 768, WSP(bf16, WS_BIG + BIG_Q), WSP(float, WS_ROWSS), PF(I_MQNN), PF(I_MQNR), WSP(float, WS_TAB), rsqrtf(96.0f) * LOG2E);
            GEMM_PHASE(3, pg8::EpiMlaKV, WSP(bf16, WS_BIG + BIG_KVL), 256, WSP(bf16, WS_W + W_C), MT, 2048, 256, WSP(bf16, WS_KV), WSP(bf16, WS_KV) + (size_t)MT * 1024, WSP(float, WS_ROWSS) + 3 * MT, PF(I_MKNN));
            if constexpr (!((KNOCK >> 12) & 1)) { PHASE_IDS const bf16* KPR = WSP(bf16, WS_BIG + BIG_KPR); bf16* KPE = WSP(bf16, WS_KPE); const float* tabM = WSP(float, WS_TAB); const float* kg = PF(I_MKNR);
              for (int row = gtid; row < MT; row += GS) {
                const v4u* src = (const v4u*)(KPR + (size_t)row * 32);
                float v[32];
#pragma unroll
                for (int q = 0; q < 4; ++q) { const v4u wv = src[q]; v[8 * q] = bflo(wv.x); v[8 * q + 1] = bfhi(wv.x); v[8 * q + 2] = bflo(wv.y); v[8 * q + 3] = bfhi(wv.y); v[8 * q + 4] = bflo(wv.z); v[8 * q + 5] = bfhi(wv.z); v[8 * q + 6] = bflo(wv.w); v[8 * q + 7] = bfhi(wv.w); }
                float ss = 0.f;
#pragma unroll
                for (int j = 0; j < 32; ++j) ss += v[j] * v[j];
                const float inv = rsqrtf(ss * (1.0f / 32.0f) + EPS);
#pragma unroll
                for (int j = 0; j < 32; ++j) v[j] = v[j] * inv * kg[j];
                if (row < ML) { const int t = row & 4095;
#pragma unroll
                    for (int hf = 0; hf < 2; ++hf) { const int pos = hf ? (t & 63) : (t >> 6);
#pragma unroll
                        for (int i = 0; i < 8; ++i) { const float c = tabM[pos * 8 + i], sn = tabM[512 + pos * 8 + i]; const float a = v[16 * hf + i], bq = v[16 * hf + 8 + i];
                            v[16 * hf + i] = a * c - bq * sn; v[16 * hf + 8 + i] = bq * c + a * sn; } } }
                v4u* dst = (v4u*)(KPE + (size_t)row * 32);
#pragma unroll
                for (int q = 0; q < 4; ++q) { v4u wv; wv.x = pk2(v[8 * q], v[8 * q + 1]); wv.y = pk2(v[8 * q + 2], v[8 * q + 3]); wv.z = pk2(v[8 * q + 4], v[8 * q + 5]); wv.w = pk2(v[8 * q + 6], v[8 * q + 7]); dst[q] = wv; } } }
            GRID_SYNC();
#ifdef DBG
            { PHASE_IDS unsigned char* ws = PWS(); const unsigned sidx = (unsigned)gtid; unsigned short* sn = (unsigned short*)(ws + DBG_SNAP);
              const int row = (sidx & 1) ? ML + (int)(hsh(sidx + 41u) % MC) : (int)(hsh(sidx + 41u) % ML); const int col = hsh(sidx + 43u) % 1024;
              sn[sidx * 4 + 0] = WSP(bf16, WS_KV)[(size_t)row * 1024 + col]; sn[sidx * 4 + 1] = (WSP(bf16, WS_KV) + (size_t)MT * 1024)[(size_t)row * 1024 + col];
              sn[sidx * 4 + 2] = WSP(bf16, WS_KPE)[(size_t)row * 32 + (col & 31)]; sn[sidx * 4 + 3] = WSP(bf16, WS_BIG + BIG_Q)[(size_t)row * 1536 + col]; }
#endif
            if constexpr (!((KNOCK >> 10) & 1)) { AttnP<96, 64, false> P{WSP(bf16, WS_BIG + BIG_Q), 1536, WSP(bf16, WS_KV), 1024, WSP(bf16, WS_KPE), WSP(bf16, WS_KV) + (size_t)MT * 1024, 1024, WSP(bf16, WS_XN), 0.f, 0.f, (const float*)(PWS() + WS_TAB + 262144)};
              for (int rep_ = 0; rep_ < ATT_REP; ++rep_)
              for (int u = vcu; u < 2048 + 128; u += G) {
                  const bool cq = u >= 2048; const int bh = cq ? u - 2048 : (u >> 4); const int bb = bh >> 4, hh_ = bh & 15; const int qrow0 = cq ? ML + bb * CTXL : bb * SEQ + (u & 15) * 256;
                  attn_unit<96, 64, false>(lds, P, bb, hh_, qrow0, cq ? 4 : 68); } }
            GRID_SYNC();
#ifdef DBG
            { PHASE_IDS unsigned char* ws = PWS(); const unsigned sidx = (unsigned)gtid;
              if (sidx < 32u) { const int q = sidx; const float* dmp = (const float*)(ws + WS_TAB + 262144); float m = -1e30f;
                for (int tt = 0; tt < 4; ++tt) for (int key = 0; key < 64; ++key) m = fmaxf(m, dmp[tt * 2048 + q * 64 + key]);
                float l = 0.f, l0 = 0.f; for (int tt = 0; tt < 4; ++tt) for (int key = 0; key < 64; ++key) { const float p = exp2f(dmp[tt * 2048 + q * 64 + key] - m); l += p; if (((key >> 2) & 1) == 0) l0 += p; }
                const float kl = dmp[4 * 2048 + q], km = dmp[4 * 2048 + 32 + q], kl0 = dmp[4 * 2048 + 64 + q]; unsigned* cw = (unsigned*)(ws + DBG_OFF) + 16;
                if (fabsf(kl - l) > 0.01f * l) atomicAdd(cw + 0, 1u); if (fabsf(km - m) > 0.01f) atomicAdd(cw + 1, 1u); if (fabsf(kl0 - l0) > 0.01f * l0) atomicAdd(cw + 2, 1u); if (fabsf(kl - 2.0f * kl0) < 0.001f * kl) atomicAdd(cw + 3, 1u); }
              { unsigned short* sn = (unsigned short*)(ws + DBG_SNAP); const int row = (sidx & 1) ? ML + (int)(hsh(sidx + 41u) % MC) : (int)(hsh(sidx + 41u) % ML); const int col = hsh(sidx + 43u) % 1024; unsigned* cw = (unsigned*)(ws + DBG_OFF) + 8;
                if (sn[sidx * 4 + 0] != WSP(bf16, WS_KV)[(size_t)row * 1024 + col]) atomicAdd(cw + 0, 1u);
                if (sn[sidx * 4 + 1] != (WSP(bf16, WS_KV) + (size_t)MT * 1024)[(size_t)row * 1024 + col]) atomicAdd(cw + 1, 1u);
                if (sn[sidx * 4 + 2] != WSP(bf16, WS_KPE)[(size_t)row * 32 + (col & 31)]) atomicAdd(cw + 2, 1u);
                if (sn[sidx * 4 + 3] != WSP(bf16, WS_BIG + BIG_Q)[(size_t)row * 1536 + col]) atomicAdd(cw + 3, 1u);
                if ((sidx & 1) && (sn[sidx * 4 + 0] != WSP(bf16, WS_KV)[(size_t)row * 1024 + col] || sn[sidx * 4 + 1] != (WSP(bf16, WS_KV) + (size_t)MT * 1024)[(size_t)row * 1024 + col])) atomicAdd(cw + 4, 1u); }
            }
        GRID_SYNC();
#endif
        } else {
            GEMM_PHASE(4, pg8::EpiDiff, WSP(bf16, WS_XN), D, WSP(bf16, WS_W + W_IN), MT, 3072, D, WSP(bf16, WS_BIG), PF(I_DQNG), PF(I_DKNG), WSP(float, WS_TAB) + 1024, 0.125f * LOG2E);
            GRID_SYNC();
            if constexpr (!((KNOCK >> 11) & 1)) { float lam; { PHASE_IDS const float d1 = wave_sum(PF(I_DLQ1)[lane] * PF(I_DLK1)[lane]), d2 = wave_sum(PF(I_DLQ2)[lane] * PF(I_DLK2)[lane]); lam = __expf(d1) - __expf(d2); }
              const float lam_init = 0.8f - 0.6f * 0.5488116360940264f;
              lam = __builtin_bit_cast(float, __builtin_amdgcn_readfirstlane(__builtin_bit_cast(int, lam))) + lam_init;
              bf16* BIG = WSP(bf16, WS_BIG);
              AttnP<64, 128, true> P{BIG, 3072, BIG + 1024, 3072, nullptr, BIG + 2048, 3072, WSP(bf16, WS_XN), lam, 1.0f - lam_init, PF(I_DSUBG)};
              for (int rep_ = 0; rep_ < ATT_REP; ++rep_)
              for (int u = vcu; u < 2048; u += G) { const int bh = u >> 5, qb = u & 31; attn_unit<64, 128, true>(lds, P, bh >> 3, bh & 7, (bh >> 3) * SEQ + qb * 128, 68); } }
            GRID_SYNC();
        }
        GEMM_PHASE(5, pg8::EpiResid, WSP(bf16, WS_XN), D, WSP(bf16, WS_W + W_OUT), Mffn, D, D, (L == 0) ? PF(I_X) : (const float*)POUT(), (L == 0) ? PF(I_CTX) : WSP(const float, WS_HCTX), POUT(), WSP(float, WS_HCTX), WSP(float, WS_MOD) + (size_t)L * 9 * 6144 + 2048);
        GRID_SYNC();
#ifdef DBG
        if constexpr (L == 0) { PHASE_IDS unsigned char* ws = PWS(); const unsigned sidx = (unsigned)gtid; const int row = hsh(sidx + 13u) % MT, col = hsh(sidx * 7u + 3u) % 1024; const bool isc = row >= ML; const int mi = isc ? 8 : (row >> 12);
            const bf16* xr = WSP(bf16, WS_XN) + (size_t)row * D; const float* w = PF(I_CWOUT) + col; float o = 0.f; for (int k = 0; k < 1024; ++k) o += h2f(xr + k) * w[(size_t)k * 1024];
            const float base = isc ? PF(I_CTX)[(size_t)(row - ML) * D + col] : PF(I_X)[(size_t)row * D + col]; const float got = isc ? WSP(float, WS_HCTX)[(size_t)(row - ML) * D + col] : POUT()[(size_t)row * D + col];
            if (dbg_bad(got, base + WSP(float, WS_MOD)[mi * 6144 + 2048 + col] * o)) dbg_flag(ws, 3); }
        GRID_SYNC();
#endif
        NORM_ROWS((const float*)POUT(), WSP(const float, WS_HCTX), PF(I_NFG) + L * D, 3072, 4096, Mffn);
        GRID_SYNC();
        GEMM_PHASE(6, pg8::EpiPair<1>, WSP(bf16, WS_XN), D, WSP(bf16, WS_W + W_GU), Mffn, 2 * FF, D, WSP(bf16, WS_BIG));
        GRID_SYNC();
#ifdef DBG
        if constexpr (L == 0) { PHASE_IDS unsigned char* ws = PWS(); const unsigned sidx = (unsigned)gtid; const int row = hsh(sidx + 17u) % MT, col = hsh(sidx * 11u + 4u) % FF;
            const bf16* xr = WSP(bf16, WS_XN) + (size_t)row * D; const float* wg = PF(I_FWG) + col; const float* wu = PF(I_FWU) + col; float g = 0.f, u = 0.f;
            for (int k = 0; k < 1024; ++k) { const float a = h2f(xr + k); g += a * wg[(size_t)k * FF]; u += a * wu[(size_t)k * FF]; }
            if (dbg_bad(h2f(WSP(bf16, WS_BIG) + (size_t)row * FF + col), silu_x(g) * u)) dbg_flag(ws, 4);
            const int row2 = hsh(sidx + 19u) % MT, col2 = hsh(sidx * 13u + 5u) % 1024; const bool isc = row2 >= ML;
            ((float*)(ws + DBG_SNAP))[sidx] = isc ? WSP(float, WS_HCTX)[(size_t)(row2 - ML) * D + col2] : POUT()[(size_t)row2 * D + col2]; }
        GRID_SYNC();
#endif
        GEMM_PHASE(7, pg8::EpiResid, WSP(bf16, WS_BIG), FF, WSP(bf16, WS_W + W_DN), Mffn, D, FF, (const float*)POUT(), WSP(const float, WS_HCTX), POUT(), WSP(float, WS_HCTX), WSP(float, WS_MOD) + (size_t)L * 9 * 6144 + 5120);
        if constexpr (L < 3) convert_weights<L + 1, 1, (Mffn == MT) ? 32 : 0>(lds, G, bx, vcu);
        if (L < 3) GRID_SYNC();
#ifdef DBG
        if constexpr (L == 0) { PHASE_IDS unsigned char* ws = PWS(); const unsigned sidx = (unsigned)gtid; const int row2 = hsh(sidx + 19u) % MT, col2 = hsh(sidx * 13u + 5u) % 1024; const bool isc = row2 >= ML; const int mi = isc ? 8 : (row2 >> 12);
            const bf16* hr = WSP(bf16, WS_BIG) + (size_t)row2 * FF; const float* w = PF(I_FWD) + col2; float o = 0.f; for (int k = 0; k < FF; ++k) o += h2f(hr + k) * w[(size_t)k * 1024];
            const float got = isc ? WSP(float, WS_HCTX)[(size_t)(row2 - ML) * D + col2] : POUT()[(size_t)row2 * D + col2];
            if (dbg_bad(got, ((float*)(ws + DBG_SNAP))[sidx] + WSP(float, WS_MOD)[mi * 6144 + 5120 + col2] * o)) dbg_flag(ws, 4); }
        GRID_SYNC();
#endif
    }
}

__global__ void __launch_bounds__(512, 2) fwd_mega(Args args) {
    extern __shared__ __attribute__((aligned(16))) unsigned char lds_raw[];
    cg::grid_group grid = cg::this_grid();
    LAS unsigned char* lds = (LAS unsigned char*)lds_raw;
    const int G = gridDim.x, bx = blockIdx.x;
    const int vcu = (G % 8 == 0) ? (bx % 8) * (G / 8) + bx / 8 : bx;
    const int NGW = G * 8, GS = G * 512;
    if (threadIdx.x < 2) ((volatile LAS unsigned*)(lds + BARGEN_OFF))[threadIdx.x] = 0u;
    __syncthreads();
    const XcdBarrier xbar = xcd_barrier_post((unsigned*)(PWS() + WS_BAR), (volatile LAS unsigned*)(lds + BARGEN_OFF));
    grid.sync();
    {
        PHASE_IDS
        unsigned char* ws = PWS();
        float* rowss = (float*)(ws + WS_ROWSS); float* tabM = (float*)(ws + WS_TAB); float* tabD = tabM + 1024; float* MOD = (float*)(ws + WS_MOD);
        const float* cvec = PF(I_C); const float* cctx = PF(I_CCTX); const float* mod_w = PF(I_MODW); const float* mod_b = PF(I_MODB);
        LAS float* sl = (LAS float*)lds; LAS float* red = sl + 9 * 1024;
        for (int i = tid; i < 9 * 1024; i += 512) { const int j = i >> 10, k = i & 1023; const float v = j < 8 ? cvec[j * 1024 + k] : cctx[k]; sl[i] = v / (1.0f + __expf(-v)); }
        __syncthreads();
        for (int item = bx; item < 4 * 96; item += G) {
            const int l = item / 96, n0 = (item % 96) * 64;
            const float* Wp = mod_w + (size_t)l * 1024 * 6144 + n0 + lane; const int k0 = wave * 128;
            float a0 = 0.f, a1 = 0.f, a2 = 0.f, a3 = 0.f, a4 = 0.f, a5 = 0.f, a6 = 0.f, a7 = 0.f, a8 = 0.f;
#pragma unroll 32
            for (int kk = 0; kk < 128; ++kk) { const float wv = Wp[(size_t)(k0 + kk) * 6144]; const LAS float* sp = sl + k0 + kk;
                a0 += sp[0] * wv; a1 += sp[1024] * wv; a2 += sp[2048] * wv; a3 += sp[3072] * wv; a4 += sp[4096] * wv; a5 += sp[5120] * wv; a6 += sp[6144] * wv; a7 += sp[7168] * wv; a8 += sp[8192] * wv; }
            LAS float* rp = red + wave * 9 * 64 + lane;
            rp[0] = a0; rp[64] = a1; rp[128] = a2; rp[192] = a3; rp[256] = a4; rp[320] = a5; rp[384] = a6; rp[448] = a7; rp[512] = a8;
            __syncthreads();
            for (int o = tid; o < 9 * 64; o += 512) { const int j = o >> 6, ln = o & 63; float s = mod_b[l * 6144 + n0 + ln];
#pragma unroll
                for (int w8 = 0; w8 < 8; ++w8) s += red[(w8 * 9 + j) * 64 + ln];
                MOD[(size_t)(l * 9 + j) * 6144 + n0 + ln] = s; }
            __syncthreads();
        }
        for (int i = gtid; i < 4 * MT; i += GS) rowss[i] = 0.f;
#ifdef DBG
        if (gtid < 64) ((unsigned*)(ws + DBG_OFF))[gtid] = 0u;
#endif
        if (bx == G - 1) {
            for (int i = tid; i < 512 + 1024; i += 512) {
                const bool dm = i >= 512; const int ii = dm ? i - 512 : i; const int nf = dm ? 16 : 8; const int pos = ii / nf, fi = ii % nf;
                const double base = dm ? 0.5623413251903491 : 0.31622776601683794;
                double f = 1.0; for (int q = 0; q < fi; ++q) f *= base;
                double a = (double)pos * f;
                const double twopi = 6.283185307179586476925; const double kq = __builtin_rint(a / twopi); a -= kq * twopi;
                double sn = a, cs = 1.0, term_s = a, term_c = 1.0; const double a2 = a * a;
                for (int q = 1; q < 16; ++q) { term_c *= -a2 / (double)((2 * q - 1) * (2 * q)); term_s *= -a2 / (double)((2 * q) * (2 * q + 1)); cs += term_c; sn += term_s; }
                float* tb = dm ? tabD : tabM; const int half = dm ? 1024 : 512;
                tb[pos * nf + fi] = (float)cs; tb[half + pos * nf + fi] = (float)sn;
            }
        }
    }
    convert_weights<0, 0>(lds, G, bx, vcu);
    GRID_SYNC();

    layer_fn<0>(lds, G, bx, vcu, xbar);
    layer_fn<1>(lds, G, bx, vcu, xbar);
    layer_fn<2>(lds, G, bx, vcu, xbar);
    layer_fn<3>(lds, G, bx, vcu, xbar);
#ifdef DBG
    GRID_SYNC();
    if (blockIdx.x == 0 && threadIdx.x == 0) { volatile unsigned* dw = (volatile unsigned*)(PWS() + DBG_OFF); unsigned m = 0; const unsigned nl = dw[4], fl = dw[5], nc = dw[6], fc = dw[7];
        m = 0; { m = (dw[16] ? 1u : 0u) + (dw[17] ? 2u : 0u) + (dw[18] ? 4u : 0u) + (dw[19] > 16u ? 8u : 0u); } (void)nc; (void)fc; (void)nl; (void)fl; POUT()[0] += 1000.0f * (float)m; }
#endif
}

extern "C" void kernel_launch(void* const* d_in, const int* in_sizes, int n_in, void* d_out, int out_size, void* d_ws, size_t ws_size, hipStream_t stream) {
    static int grid_blocks = 0;
    if (grid_blocks == 0) {
        if (n_in != 34 || ws_size < WS_END) { fprintf(stderr, "kernel_launch: unexpected n_in %d or ws_size %zu (< %zu)\n", n_in, ws_size, (size_t)WS_END); grid_blocks = -1; return; }
        int dev = 0, cus = 0, per_cu = 0;
        (void)hipGetDevice(&dev);
        (void)hipDeviceGetAttribute(&cus, hipDeviceAttributeMultiprocessorCount, dev);
        (void)hipFuncSetAttribute((const void*)fwd_mega, hipFuncAttributeMaxDynamicSharedMemorySize, LDS_BYTES);
        (void)hipOccupancyMaxActiveBlocksPerMultiprocessor(&per_cu, (const void*)fwd_mega, 512, LDS_BYTES);
        if (per_cu < 1) per_cu = 1;
        grid_blocks = cus * per_cu;
        fprintf(stderr, "grid %d (cus %d per_cu %d) ws_size %zu\n", grid_blocks, cus, per_cu, ws_size);
    }
    if (grid_blocks < 0) return;
    (void)hipMemsetAsync((char*)d_ws + WS_BAR, 0, XCD_BAR_WORDS * 4, stream);
    Args a{};
    for (int i = 0; i < 34; ++i) a.in[i] = (const float*)d_in[i];
    a.out = (float*)d_out; a.ws = (unsigned char*)d_ws;
    void* kargs[] = {&a};
    hipError_t e = hipLaunchCooperativeKernel((void*)fwd_mega, dim3(grid_blocks), dim3(512), kargs, LDS_BYTES, stream);
    if (e != hipSuccess) fprintf(stderr, "cooperative launch failed: %s (grid %d)\n", hipGetErrorString(e), grid_blocks);
}
```

```cpp
#ifndef ATT_REP
#define ATT_REP 1
#endif
#include <hip/hip_runtime.h>
#include <hip/hip_cooperative_groups.h>
#include <cstdio>
#include <cstdint>
namespace cg = cooperative_groups;
namespace pg8 {
#define PG8_LAS __attribute__((address_space(3)))
typedef unsigned short bf16_t;
typedef short bf16x8 __attribute__((ext_vector_type(8)));
typedef float f32x4 __attribute__((ext_vector_type(4)));
typedef unsigned u32x4 __attribute__((ext_vector_type(4)));
typedef _Float16 f16x8 __attribute__((ext_vector_type(8)));
typedef _Float16 f16x2 __attribute__((ext_vector_type(2)));
typedef float f32x2v __attribute__((ext_vector_type(2)));
constexpr int BM = 256, BK = 64, HALF = 128, HTB = HALF * BK * 2  , STAGE_BYTES = 8 * HTB, NXCD = 8, WGM = 8;

__host__ __device__ __forceinline__ int lds_byte(int r, int c) { const int st = (r >> 4) * 2 + (c >> 5), rr = r & 15, cc = c & 31, ob = rr * 64 + cc * 2; return st * 1024 + (ob ^ (((ob >> 9) & 1) << 5)); }
__host__ __device__ __forceinline__ void stage_rc(int b, int& R, int& C) { const int st = b / 1024, sb = b % 1024, swz = sb ^ (((sb >> 9) & 1) << 5); R = (st >> 1) * 16 + swz / 64; C = (st & 1) * 32 + (swz % 64) / 2; }
__host__ __device__ __forceinline__ int perm32(int rho) { const int n = rho >> 4, i = rho & 15; return 8 * (i >> 2) + 4 * n + (i & 3); }

struct Unit { int pm, pn; };
struct Gemm { const bf16_t* A; const bf16_t* Bt; int M, N, K, lda; };

struct StaticOrder {
    int nM, nN, nwg, G, c;
    __host__ __device__ void init(int M, int N, int G_, int c_) { nM = M / BM; nN = N / BM; nwg = nM * nN; G = G_; c = c_; }
    __host__ __device__ bool next(int i, Unit& u) const {
        const long L = (long)i * G + c; if (L >= nwg) return false;
        int wgid = (int)L; { const int q = nwg / NXCD, r = nwg % NXCD, xcd = wgid % NXCD, off = wgid / NXCD; wgid = (xcd < r ? xcd * (q + 1) : r * (q + 1) + (xcd - r) * q) + off; }
        const int nig = WGM * nN, gid = wgid / nig, fm = gid * WGM, gsz = (nM - fm) < WGM ? (nM - fm) : WGM;
        u.pm = fm + ((wgid % nig) % gsz); u.pn = (wgid % nig) / gsz; return true;
    }
    __device__ __forceinline__ void a_ready(const Unit&) const {}
    __device__ __forceinline__ void done(const Unit&) const {}
};

constexpr int ML_ = 32768, MT_ = 34816, DM_ = 1024;
constexpr float EPS_ = 1e-6f;
__device__ __forceinline__ unsigned cvt_pk_bf16(float lo, float hi) { const f32x2v v = {lo, hi}; return __builtin_bit_cast(unsigned, __builtin_convertvector(v, f16x2)); }
__device__ __forceinline__ u32x4 pack8(const f32x4 a, const f32x4 b) { u32x4 w; w.x = cvt_pk_bf16(a[0], a[1]); w.y = cvt_pk_bf16(a[2], a[3]); w.z = cvt_pk_bf16(b[0], b[1]); w.w = cvt_pk_bf16(b[2], b[3]); return w; }
__device__ __forceinline__ float sum4sq(const f32x4 a) { return (a[0] * a[0] + a[1] * a[1]) + (a[2] * a[2] + a[3] * a[3]); }
__device__ __forceinline__ float lanex(float v, int lane, int mask) { return __builtin_bit_cast(float, __builtin_amdgcn_ds_bpermute((lane ^ mask) << 2, __builtin_bit_cast(int, v))); }
__device__ __forceinline__ float red_fq(float s, int fr, int fq) { const int lane = fr | (fq << 4); s += lanex(s, lane, 16); s += lanex(s, lane, 32); return s; }
__device__ __forceinline__ f32x4 shfl4x(const f32x4 v, int fr, int fq, int mask) { const int lane = fr | (fq << 4); f32x4 r; r[0] = lanex(v[0], lane, mask); r[1] = lanex(v[1], lane, mask); r[2] = lanex(v[2], lane, mask); r[3] = lanex(v[3], lane, mask); return r; }
__device__ __forceinline__ float silu_fast(float x) { return x * __builtin_amdgcn_rcpf(1.0f + __builtin_amdgcn_exp2f(-1.4426950408889634f * x)); }

struct EpiResid {
    static constexpr bool PERM = false, AFTER_DRAIN = false;
    const float* base_lat; const float* base_ctx; float* out_lat; float* out_ctx; const float* gate;
    __device__ __forceinline__ void operator()(const f32x4 (&acc)[2][2][4][2], const Unit& u, int wr, int wc, int fr, int fq) const {
        const int rowt = u.pm * BM; const bool isctx = rowt >= ML_;
        const float* base = isctx ? base_ctx - (size_t)ML_ * DM_ : base_lat; float* out = isctx ? out_ctx - (size_t)ML_ * DM_ : out_lat;
        const int mi = isctx ? 8 : (rowt >> 12);
        const int col0 = u.pn * BM + wc * 32 + 4 * fq;
        const float* gp = gate + mi * 6144 + col0;
        f32x4 gv[2][2];
#pragma unroll
        for (int bj = 0; bj < 2; ++bj)
#pragma unroll
            for (int n = 0; n < 2; ++n) gv[bj][n] = *(const f32x4*)(gp + bj * HALF + n * 16);
#pragma unroll
        for (int ai = 0; ai < 2; ++ai)
#pragma unroll
            for (int m = 0; m < 4; ++m) { const size_t off = (size_t)(rowt + ai * HALF + wr * 64 + m * 16 + fr) * DM_ + col0;
#pragma unroll
                for (int bj = 0; bj < 2; ++bj)
#pragma unroll
                    for (int n = 0; n < 2; ++n) { const f32x4 bs = *(const f32x4*)(base + off + bj * HALF + n * 16); *(f32x4*)(out + off + bj * HALF + n * 16) = bs + gv[bj][n] * acc[ai][bj][m][n]; } }
    }
};
template <int MODE> struct EpiPair {
    static constexpr bool PERM = true, AFTER_DRAIN = false;
    bf16_t* O;
    __device__ __forceinline__ void operator()(const f32x4 (&acc)[2][2][4][2], const Unit& u, int wr, int wc, int fr, int fq) const {
        const int row0 = u.pm * BM + wr * 64 + fr;
        constexpr int ldo = MODE == 0 ? 2048 : 2816;
        if (MODE == 0 && u.pn < 4) {
#pragma unroll
            for (int ai = 0; ai < 2; ++ai)
#pragma unroll
                for (int m = 0; m < 4; ++m) { bf16_t* rowp = O + (size_t)(row0 + ai * HALF + m * 16) * ldo + u.pn * BM + wc * 32 + 8 * fq;
#pragma unroll
                    for (int bj = 0; bj < 2; ++bj) *(u32x4*)(rowp + bj * HALF) = pack8(acc[ai][bj][m][0], acc[ai][bj][m][1]); }
        } else {
            const int colo = (MODE == 0 ? 1024 + (u.pn - 4) * 128 : u.pn * 128) + wc * 32 + 8 * fq;
#pragma unroll
            for (int ai = 0; ai < 2; ++ai)
#pragma unroll
                for (int m = 0; m < 4; ++m) { bf16_t* rowp = O + (size_t)(row0 + ai * HALF + m * 16) * ldo + colo;
                    f32x4 r0, r1;
#pragma unroll
                    for (int e = 0; e < 4; ++e) {
                        if (MODE == 0) { r0[e] = acc[ai][0][m][0][e] * acc[ai][1][m][0][e]; r1[e] = acc[ai][0][m][1][e] * acc[ai][1][m][1][e]; }
                        else { r0[e] = silu_fast(acc[ai][0][m][0][e]) * acc[ai][1][m][0][e]; r1[e] = silu_fast(acc[ai][0][m][1][e]) * acc[ai][1][m][1][e]; } }
                    *(u32x4*)rowp = pack8(r0, r1); }
        }
    }
};
struct EpiMlaIn {
    static constexpr bool PERM = true, AFTER_DRAIN = false;
    bf16_t* QL; bf16_t* KVL; bf16_t* KPR; float* rowss;
    __device__ __forceinline__ void operator()(const f32x4 (&acc)[2][2][4][2], const Unit& u, int wr, int wc, int fr, int fq) const {
        const int row0 = u.pm * BM + wr * 64 + fr;
        if (u.pn == 4) {
            if (wc == 0) {
#pragma unroll
                for (int ai = 0; ai < 2; ++ai)
#pragma unroll
                    for (int m = 0; m < 4; ++m) *(u32x4*)(KPR + (size_t)(row0 + ai * HALF + m * 16) * 32 + 8 * fq) = pack8(acc[ai][0][m][0], acc[ai][0][m][1]);
            }
            return;
        }
        bf16_t* O = u.pn < 3 ? QL + u.pn * BM : KVL; const int ldo = u.pn < 3 ? 768 : 256;
#pragma unroll
        for (int ai = 0; ai < 2; ++ai)
#pragma unroll
            for (int m = 0; m < 4; ++m) { const int row = row0 + ai * HALF + m * 16; bf16_t* rowp = O + (size_t)row * ldo + wc * 32 + 8 * fq;
                float s = 0.f;
#pragma unroll
                for (int bj = 0; bj < 2; ++bj) { *(u32x4*)(rowp + bj * HALF) = pack8(acc[ai][bj][m][0], acc[ai][bj][m][1]); s += sum4sq(acc[ai][bj][m][0]) + sum4sq(acc[ai][bj][m][1]); }
                s = red_fq(s, fr, fq);
                if (fq == 0) atomicAdd(rowss + u.pn * MT_ + row, s); }
    }
};
struct EpiMlaQ {
    static constexpr bool PERM = true, AFTER_DRAIN = false;
    bf16_t* Q; const float* rowss; const float* g_nope; const float* g_rope; const float* tab; float scale;
    __device__ __forceinline__ void operator()(const f32x4 (&acc)[2][2][4][2], const Unit& u, int wr, int wc, int fr, int fq) const {
        const int row0 = u.pm * BM + wr * 64 + fr;
        if (u.pn < 4) {
            const int head = 4 * u.pn + wc;
            f32x4 g[2][2];
#pragma unroll
            for (int bj = 0; bj < 2; ++bj)
#pragma unroll
                for (int n = 0; n < 2; ++n) g[bj][n] = *(const f32x4*)(g_nope + 32 * bj + 8 * fq + 4 * n);
#pragma unroll
            for (int ai = 0; ai < 2; ++ai)
#pragma unroll
                for (int m = 0; m < 4; ++m) { const int row = row0 + ai * HALF + m * 16;
                    const float rs = rsqrtf((rowss[row] + rowss[MT_ + row] + rowss[2 * MT_ + row]) * (1.0f / 768.0f) + EPS_);
                    float ss = 0.f;
#pragma unroll
                    for (int bj = 0; bj < 2; ++bj) ss += sum4sq(acc[ai][bj][m][0]) + sum4sq(acc[ai][bj][m][1]);
                    ss = red_fq(ss, fr, fq);
                    const float inv = rs * rsqrtf(rs * rs * ss * (1.0f / 64.0f) + EPS_) * scale;
                    bf16_t* rowp = Q + (size_t)row * 1536 + head * 96 + 8 * fq;
#pragma unroll
                    for (int bj = 0; bj < 2; ++bj) *(u32x4*)(rowp + 32 * bj) = pack8(acc[ai][bj][m][0] * inv * g[bj][0], acc[ai][bj][m][1] * inv * g[bj][1]); }
        } else {
            f32x4 g[2];
#pragma unroll
            for (int n = 0; n < 2; ++n) g[n] = *(const f32x4*)(g_rope + 8 * fq + 4 * n);
            const bool isctx = u.pm * BM >= ML_;
#pragma unroll
            for (int ai = 0; ai < 2; ++ai)
#pragma unroll
                for (int m = 0; m < 4; ++m) { const int row = row0 + ai * HALF + m * 16;
                    const float rs = rsqrtf((rowss[row] + rowss[MT_ + row] + rowss[2 * MT_ + row]) * (1.0f / 768.0f) + EPS_);
                    const int t = row & 4095; const int pos = (fq >> 1) ? (t & 63) : (t >> 6);
                    f32x4 cs[2], sn[2];
#pragma unroll
                    for (int n = 0; n < 2; ++n) { cs[n] = *(const f32x4*)(tab + pos * 8 + 4 * n); sn[n] = *(const f32x4*)(tab + 512 + pos * 8 + 4 * n); }
#pragma unroll
                    for (int bj = 0; bj < 2; ++bj) { const int head = 8 * (u.pn - 4) + 4 * bj + wc;
                        float ss = red_fq(sum4sq(acc[ai][bj][m][0]) + sum4sq(acc[ai][bj][m][1]), fr, fq);
                        const float inv = rs * rsqrtf(rs * rs * ss * (1.0f / 32.0f) + EPS_);
                        f32x4 y[2];
#pragma unroll
                        for (int n = 0; n < 2; ++n) { y[n] = acc[ai][bj][m][n] * inv * g[n];
                            const f32x4 yp = shfl4x(y[n], fr, fq, 16);
                            if (!isctx) y[n] = (fq & 1) ? (y[n] * cs[n] + yp * sn[n]) : (y[n] * cs[n] - yp * sn[n]);
                            y[n] = y[n] * scale; }
                        *(u32x4*)(Q + (size_t)row * 1536 + head * 96 + 64 + 8 * fq) = pack8(y[0], y[1]); } }
        }
    }
};
struct EpiMlaKV {
    static constexpr bool PERM = true, AFTER_DRAIN = false;
    bf16_t* K; bf16_t* V; const float* rowss; const float* g_nope;
    __device__ __forceinline__ void operator()(const f32x4 (&acc)[2][2][4][2], const Unit& u, int wr, int wc, int fr, int fq) const {
        const int row0 = u.pm * BM + wr * 64 + fr; const bool isk = u.pn < 4; const int head = 4 * (u.pn & 3) + wc;
        float eps_l = EPS_; asm volatile("" : "+v"(eps_l));
        bf16_t* obase = (isk ? K : V) + head * 64 + 8 * fq;
#pragma unroll
        for (int ai = 0; ai < 2; ++ai)
#pragma unroll
            for (int m = 0; m < 4; ++m) { const int row = row0 + ai * HALF + m * 16;
                const float rs = rsqrtf(rowss[row] * (1.0f / 256.0f) + eps_l);
                float inv = rs;
                if (isk) { float ss = 0.f;
#pragma unroll
                    for (int bj = 0; bj < 2; ++bj) ss += sum4sq(acc[ai][bj][m][0]) + sum4sq(acc[ai][bj][m][1]);
                    ss = red_fq(ss, fr, fq);
                    inv = rs * rsqrtf(rs * rs * ss * (1.0f / 64.0f) + eps_l); }
                bf16_t* rowp = obase + (size_t)row * 1024;
#pragma unroll
                for (int bj = 0; bj < 2; ++bj) { f32x4 a = acc[ai][bj][m][0] * inv, b = acc[ai][bj][m][1] * inv;
                    if (isk) { a = a * *(const f32x4*)(g_nope + 32 * bj + 8 * fq); b = b * *(const f32x4*)(g_nope + 32 * bj + 8 * fq + 4); }
                    *(u32x4*)(rowp + 32 * bj) = pack8(a, b); } }
    }
};
struct EpiDiff {
    static constexpr bool PERM = true, AFTER_DRAIN = false;
    bf16_t* O; const float* gq; const float* gk; const float* tab; float scale;
    __device__ __forceinline__ void operator()(const f32x4 (&acc)[2][2][4][2], const Unit& u, int wr, int wc, int fr, int fq) const {
        const int row0 = u.pm * BM + wr * 64 + fr;
        if (u.pn >= 8) {
#pragma unroll
            for (int ai = 0; ai < 2; ++ai)
#pragma unroll
                for (int m = 0; m < 4; ++m) { bf16_t* rowp = O + (size_t)(row0 + ai * HALF + m * 16) * 3072 + 2048 + (u.pn - 8) * 256 + wc * 64 + 8 * fq;
#pragma unroll
                    for (int bj = 0; bj < 2; ++bj) *(u32x4*)(rowp + 32 * bj) = pack8(acc[ai][bj][m][0], acc[ai][bj][m][1]); }
            return;
        }
        const bool isq = u.pn < 4; const int unit = 4 * (u.pn & 3) + wc; const float* gp = isq ? gq : gk; const float osc = isq ? scale : 1.0f;
        float eps_l = EPS_; asm volatile("" : "+v"(eps_l));
        const bool isctx = u.pm * BM >= ML_;
        f32x4 g[2][2];
#pragma unroll
        for (int bj = 0; bj < 2; ++bj)
#pragma unroll
            for (int n = 0; n < 2; ++n) g[bj][n] = *(const f32x4*)(gp + 32 * bj + 8 * fq + 4 * n);
#pragma unroll
        for (int ai = 0; ai < 2; ++ai)
#pragma unroll
            for (int m = 0; m < 4; ++m) { const int row = row0 + ai * HALF + m * 16;
                float ss = 0.f;
#pragma unroll
                for (int bj = 0; bj < 2; ++bj) ss += sum4sq(acc[ai][bj][m][0]) + sum4sq(acc[ai][bj][m][1]);
                ss = red_fq(ss, fr, fq);
                const float inv = rsqrtf(ss * (1.0f / 64.0f) + eps_l);
                const int t = row & 4095;
                bf16_t* rowp = O + (size_t)row * 3072 + (isq ? 0 : 1024) + unit * 64 + 8 * fq;
#pragma unroll
                for (int bj = 0; bj < 2; ++bj) { const int pos = bj ? (t & 63) : (t >> 6);
                    f32x4 y[2];
#pragma unroll
                    for (int n = 0; n < 2; ++n) { y[n] = acc[ai][bj][m][n] * inv * g[bj][n];
                        const f32x4 yp = shfl4x(y[n], fr, fq, 32);
                        if (!isctx) { const f32x4 cs = *(const f32x4*)(tab + pos * 16 + 8 * (fq & 1) + 4 * n), sn = *(const f32x4*)(tab + 1024 + pos * 16 + 8 * (fq & 1) + 4 * n);
                            y[n] = (fq >> 1) ? (y[n] * cs + yp * sn) : (y[n] * cs - yp * sn); }
                        y[n] = y[n] * osc; }
                    *(u32x4*)(rowp + 32 * bj) = pack8(y[0], y[1]); } }
    }
};
struct EpiStore {
    static constexpr bool PERM = true, AFTER_DRAIN = false;
    bf16_t* O; int ldo;
    __device__ __forceinline__ void operator()(const f32x4 (&acc)[2][2][4][2], const Unit& u, int wr, int wc, int fr, int fq) const {
        const int row0 = u.pm * BM + wr * 64 + fr;
#pragma unroll
        for (int ai = 0; ai < 2; ++ai)
#pragma unroll
            for (int m = 0; m < 4; ++m) { bf16_t* rowp = O + (size_t)(row0 + ai * HALF + m * 16) * ldo + u.pn * BM + wc * 32 + 8 * fq;
#pragma unroll
                for (int bj = 0; bj < 2; ++bj) *(u32x4*)(rowp + bj * HALF) = pack8(acc[ai][bj][m][0], acc[ai][bj][m][1]); }
    }
};

template <class Epi, class Sched, bool ALIGN_EPI = false, bool SP2 = false>
__device__ __forceinline__ void gemm_phase(PG8_LAS unsigned char* lds, const Gemm g, const Sched& S, const Epi& E) {
    int tid_o = threadIdx.x; asm volatile("" : "+v"(tid_o));
    const int tid = tid_o, wid = __builtin_amdgcn_readfirstlane(tid >> 6), lane = tid & 63, wr = wid >> 2, wc = wid & 3, fr = lane & 15, fq = lane >> 4;
    const int K = g.K, nt = K / BK;
    unsigned voffA[2], voffB[2];
#pragma unroll
    for (int i = 0; i < 2; ++i) { int R, C; stage_rc(tid * 16 + i * 8192, R, C); const int Rb = Epi::PERM ? ((R & ~31) + perm32(R & 31)) : R;
        voffA[i] = (unsigned)(R * g.lda + C) * 2u; voffB[i] = (unsigned)(Rb * K + C) * 2u; }
    const size_t kstep = (size_t)(BK * 2);
    const size_t hstep = (size_t)HALF * K * 2; const size_t hstepA = (size_t)HALF * g.lda * 2; const size_t tstepA = 2 * hstepA;
    const size_t tstep = 2 * hstep;
    const unsigned ldsw = (unsigned)wid * 1024u;
    const int aoff = lds_byte(wr * 64 + fr, fq * 8), boff = lds_byte(wc * 32 + fr, fq * 8);
#define PG8_SA(b, h) (((b) * 2 + (h)) * HTB)
#define PG8_SB(b, h) ((4 + (b) * 2 + (h)) * HTB)
#define PG8_STAGE(bufoff, gbase, voff) do { _Pragma("unroll") for (int _i = 0; _i < 2; ++_i) \
        __builtin_amdgcn_global_load_lds((const unsigned*)((const char*)(gbase) + (voff)[_i]), (PG8_LAS unsigned*)(lds + (bufoff) + ldsw + _i * 8192), 16, 0, 0); } while (0)
#define PG8_LDA(dst, b, h) do { _Pragma("unroll") for (int m = 0; m < 4; ++m) _Pragma("unroll") for (int k = 0; k < 2; ++k) dst[m][k] = *(const PG8_LAS bf16x8*)(lds + PG8_SA(b, h) + aoff + m * 2048 + k * 1024); } while (0)
#define PG8_LDB(dst, b, h) do { _Pragma("unroll") for (int n = 0; n < 2; ++n) _Pragma("unroll") for (int k = 0; k < 2; ++k) dst[n][k] = *(const PG8_LAS bf16x8*)(lds + PG8_SB(b, h) + boff + n * 2048 + k * 1024); } while (0)
#define PG8_MMA(ai, bj, At, Bt) do { __builtin_amdgcn_s_setprio(1); _Pragma("unroll") for (int m = 0; m < 4; ++m) _Pragma("unroll") for (int n = 0; n < 2; ++n) _Pragma("unroll") for (int k = 0; k < 2; ++k) \
        acc[ai][bj][m][n] = __builtin_amdgcn_mfma_f32_16x16x32_f16(__builtin_bit_cast(f16x8, Bt[n][k]), __builtin_bit_cast(f16x8, At[m][k]), acc[ai][bj][m][n], 0, 0, 0); __builtin_amdgcn_s_setprio(0); } while (0)
#define PG8_WAIT_V(n) asm volatile("s_waitcnt vmcnt(" #n ")" ::: "memory")
#define PG8_WAIT_L(n) asm volatile("s_waitcnt lgkmcnt(" #n ")" ::: "memory")
#define PG8_BAR __builtin_amdgcn_s_barrier()
#define PG8_SCHED __builtin_amdgcn_sched_barrier(0)
    Unit cur, nxt; int ui = 0;
    if (!S.next(0, cur)) return;
    f32x4 acc[2][2][4][2];
#pragma unroll
    for (int a = 0; a < 2; ++a)
#pragma unroll
        for (int b = 0; b < 2; ++b)
#pragma unroll
            for (int m = 0; m < 4; ++m)
#pragma unroll
                for (int n = 0; n < 2; ++n) acc[a][b][m][n] = (f32x4){0.f, 0.f, 0.f, 0.f};
    bf16x8 At[4][2], B0[2][2], B1[2][2];
    const char* cA = (const char*)g.A + (size_t)cur.pm * tstepA; const char* cB = (const char*)g.Bt + (size_t)cur.pn * tstep;
    S.a_ready(cur);
    if constexpr (SP2) {
        PG8_STAGE(PG8_SB(0, 0), cB, voffB); PG8_STAGE(PG8_SB(0, 1), cB + hstep, voffB); PG8_STAGE(PG8_SA(0, 0), cA, voffA); PG8_STAGE(PG8_SA(0, 1), cA + hstepA, voffA);
        if (wr == 1) PG8_BAR;
        PG8_WAIT_V(2); PG8_BAR;
        PG8_STAGE(PG8_SB(1, 0), cB + kstep, voffB); PG8_STAGE(PG8_SA(1, 0), cA + kstep, voffA); PG8_STAGE(PG8_SB(1, 1), cB + hstep + kstep, voffB);
        PG8_WAIT_V(6); PG8_BAR;
    } else {
        PG8_STAGE(PG8_SB(0, 0), cB, voffB); PG8_STAGE(PG8_SA(0, 0), cA, voffA); PG8_STAGE(PG8_SB(0, 1), cB + hstep, voffB); PG8_STAGE(PG8_SA(0, 1), cA + hstepA, voffA);
        if (wr == 1) PG8_BAR;
        PG8_WAIT_V(4); PG8_BAR;
        PG8_STAGE(PG8_SB(1, 0), cB + kstep, voffB); PG8_STAGE(PG8_SA(1, 0), cA + kstep, voffA); PG8_STAGE(PG8_SB(1, 1), cB + hstep + kstep, voffB);
        PG8_WAIT_V(6); PG8_BAR;
    }
    for (;;) {
        const bool has_next = S.next(ui + 1, nxt);
        const char* nA = has_next ? (const char*)g.A + (size_t)nxt.pm * tstepA : cA; const char* nB = has_next ? (const char*)g.Bt + (size_t)nxt.pn * tstep : cB;
        for (int t = 0; t < nt; t += 2) {
            const bool last = (t == nt - 2);
            const char* a1 = cA + (size_t)(t + 1) * kstep;
            const char* a2 = last ? nA : cA + (size_t)(t + 2) * kstep; const char* b2 = last ? nB : cB + (size_t)(t + 2) * kstep;
            const char* a3 = a2 + kstep; const char* b3 = b2 + kstep;
            if (last && has_next) S.a_ready(nxt);
            if constexpr (SP2) {
            PG8_LDB(B0, 0, 0); PG8_LDB(B1, 0, 1); PG8_SCHED; PG8_LDA(At, 0, 0); PG8_STAGE(PG8_SA(1, 1), a1 + hstepA, voffA);
            PG8_WAIT_V(8); PG8_WAIT_L(0); PG8_BAR; PG8_MMA(0, 0, At, B0); PG8_MMA(0, 1, At, B1); PG8_BAR; PG8_SCHED;
            PG8_LDA(At, 0, 1); PG8_STAGE(PG8_SB(0, 0), b2, voffB); PG8_STAGE(PG8_SB(0, 1), b2 + hstep, voffB); PG8_STAGE(PG8_SA(0, 0), a2, voffA);
            PG8_WAIT_V(8); PG8_WAIT_L(0); PG8_BAR; PG8_MMA(1, 0, At, B0); PG8_MMA(1, 1, At, B1); PG8_BAR; PG8_SCHED;
            PG8_LDB(B0, 1, 0); PG8_LDB(B1, 1, 1); PG8_SCHED; PG8_LDA(At, 1, 0); PG8_STAGE(PG8_SA(0, 1), a2 + hstepA, voffA);
            PG8_WAIT_V(8); PG8_WAIT_L(0); PG8_BAR; PG8_MMA(0, 0, At, B0); PG8_MMA(0, 1, At, B1); PG8_BAR; PG8_SCHED;
            PG8_LDA(At, 1, 1); PG8_STAGE(PG8_SB(1, 0), b3, voffB); PG8_STAGE(PG8_SB(1, 1), b3 + hstep, voffB); PG8_STAGE(PG8_SA(1, 0), a3, voffA);
            PG8_WAIT_V(8); PG8_WAIT_L(0); PG8_BAR; PG8_MMA(1, 0, At, B0); PG8_MMA(1, 1, At, B1); PG8_BAR; PG8_SCHED;
            } else {
            PG8_LDB(B0, 0, 0); PG8_SCHED; PG8_LDA(At, 0, 0); PG8_STAGE(PG8_SA(1, 1), a1 + hstepA, voffA);
            PG8_WAIT_L(8); PG8_BAR; PG8_WAIT_L(0); PG8_MMA(0, 0, At, B0); PG8_BAR; PG8_SCHED;
            PG8_LDB(B1, 0, 1); PG8_STAGE(PG8_SB(0, 0), b2, voffB);
            PG8_BAR; PG8_WAIT_L(0); PG8_MMA(0, 1, At, B1); PG8_BAR;
            PG8_LDA(At, 0, 1); PG8_STAGE(PG8_SA(0, 0), a2, voffA);
            PG8_BAR; PG8_WAIT_L(0); PG8_MMA(1, 0, At, B0); PG8_BAR; PG8_SCHED;
            PG8_STAGE(PG8_SB(0, 1), b2 + hstep, voffB);
            PG8_WAIT_V(6); PG8_BAR; PG8_MMA(1, 1, At, B1); PG8_BAR;
            PG8_LDB(B0, 1, 0); PG8_SCHED; PG8_LDA(At, 1, 0); PG8_STAGE(PG8_SA(0, 1), a2 + hstepA, voffA);
            PG8_WAIT_L(8); PG8_BAR; PG8_WAIT_L(0); PG8_MMA(0, 0, At, B0); PG8_BAR; PG8_SCHED;
            PG8_LDB(B1, 1, 1); PG8_STAGE(PG8_SB(1, 0), b3, voffB);
            PG8_BAR; PG8_WAIT_L(0); PG8_MMA(0, 1, At, B1); PG8_BAR;
            PG8_LDA(At, 1, 1); PG8_STAGE(PG8_SA(1, 0), a3, voffA);
            PG8_BAR; PG8_WAIT_L(0); PG8_MMA(1, 0, At, B0); PG8_BAR; PG8_SCHED;
            PG8_STAGE(PG8_SB(1, 1), b3 + hstep, voffB);
            PG8_WAIT_V(6); PG8_BAR; PG8_MMA(1, 1, At, B1); PG8_BAR;
            }
        }
        if constexpr (ALIGN_EPI) { if (wr == 0) PG8_BAR; }
        if constexpr (!Epi::AFTER_DRAIN) { int t2 = threadIdx.x; asm volatile("" : "+v"(t2)); const int fr2 = t2 & 15, fq2 = (t2 >> 4) & 3; E(acc, cur, wr, wc, fr2, fq2); S.done(cur); }
        if (!has_next) break;
#pragma unroll
        for (int a = 0; a < 2; ++a)
#pragma unroll
            for (int b = 0; b < 2; ++b)
#pragma unroll
                for (int m = 0; m < 4; ++m)
#pragma unroll
                    for (int n = 0; n < 2; ++n) acc[a][b][m][n] = (f32x4){0.f, 0.f, 0.f, 0.f};
        cur = nxt; cA = nA; cB = nB; ++ui;
        if constexpr (ALIGN_EPI) { if (wr == 1) PG8_BAR; }
    }
    PG8_WAIT_V(0);
    if constexpr (!ALIGN_EPI) { if (wr == 0) PG8_BAR; }
    PG8_BAR;
    if constexpr (Epi::AFTER_DRAIN) { E.fused(acc, cur, wr, wc, fr, fq, lds, wid, lane); S.done(cur); }
#undef PG8_SA
#undef PG8_SB
#undef PG8_STAGE
#undef PG8_LDA
#undef PG8_LDB
#undef PG8_MMA
#undef PG8_WAIT_V
#undef PG8_WAIT_L
#undef PG8_BAR
#undef PG8_SCHED
}
}
#define LAS __attribute__((address_space(3)))
typedef unsigned short bf16;
typedef unsigned v4u __attribute__((ext_vector_type(4)));
typedef unsigned v2u __attribute__((ext_vector_type(2)));
typedef float f32x4 __attribute__((ext_vector_type(4)));
typedef float f32x16 __attribute__((ext_vector_type(16)));
typedef short bf16x8 __attribute__((ext_vector_type(8)));
constexpr int D = 1024, NBATCH = 8, SEQ = 4096, CTXL = 256, FF = 2816;
constexpr int ML = NBATCH * SEQ, MC = NBATCH * CTXL, MT = ML + MC;
constexpr float EPS = 1e-6f;
constexpr float LOG2E = 1.4426950408889634f;
constexpr size_t MiB = 1u << 20;
constexpr size_t WS_ROWSS = 0;
constexpr size_t WS_TAB = 1 * MiB;
constexpr size_t WS_MOD = 2 * MiB;
constexpr size_t WS_HCTX = 4 * MiB;
constexpr size_t WS_W = 12 * MiB;
constexpr size_t W_IN = 0, W_B = 6 * MiB, W_C = 9 * MiB, W_OUT = 10 * MiB, W_GU = 12 * MiB, W_DN = 23 * MiB;
constexpr size_t WS_XN = 42 * MiB;
constexpr size_t WS_BIG = 110 * MiB;
constexpr size_t WS_KV = 314 * MiB;
constexpr size_t WS_KPE = 450 * MiB;
constexpr size_t WS_END = 454 * MiB;
constexpr size_t BIG_KVL = 52 * MiB, BIG_KPR = 70 * MiB;
constexpr size_t BIG_Q = 86 * MiB;
constexpr int LDS_BYTES = 147456;
#define XB_TMO      128
#define XB_XCNT(j)  (256  + 64 * (j))
#define XB_XSUB(j)  (1280 + 64 * (j))
#define XB_XGEN(j)  (2304 + 64 * (j))
#define XB_TOP      3328
#define XB_TOPGEN   3392
#define XCD_BAR_WORDS 3456
#define XB_SPIN_CAP (1u << 18)

__device__ __forceinline__ unsigned xb_ld(unsigned* p)              { return __hip_atomic_load(p, __ATOMIC_RELAXED, __HIP_MEMORY_SCOPE_AGENT); }
__device__ __forceinline__ unsigned xb_add(unsigned* p, unsigned v) { return __hip_atomic_fetch_add(p, v, __ATOMIC_RELAXED, __HIP_MEMORY_SCOPE_AGENT); }
__device__ __forceinline__ unsigned xb_xcc_id() { return (unsigned)__builtin_amdgcn_s_getreg((3 << 11) | 20) & 0xFu; }
#define XB_SPIN(cond, bar) do { unsigned _sp = 0; while (cond) { __builtin_amdgcn_s_sleep(1); \
    if ((++_sp & 255u) == 0u) { if (xb_ld(&(bar)[XB_TMO])) break; if (_sp > XB_SPIN_CAP) { atomicAdd(&(bar)[XB_TMO], 1u); break; } } } } while (0)

struct XcdBarrier {
    unsigned* bar; unsigned x;
    volatile LAS unsigned* st;
};

__device__ __forceinline__ XcdBarrier xcd_barrier_post(unsigned* bar, volatile LAS unsigned* st) {
    XcdBarrier b; b.bar = bar; b.x = xb_xcc_id(); b.st = st;
    if (threadIdx.x == 0) (void)xb_add(&bar[XB_XCNT(b.x)], 1u);
    return b;
}
__device__ __forceinline__ void xcd_barrier_complete(unsigned* bar, unsigned x, unsigned& nloc, unsigned& nx) {
    const unsigned G = gridDim.x * gridDim.y * gridDim.z;
    unsigned sum, cnt, mine, sp = 0u;
    for (;;) {
        sum = 0u; cnt = 0u; mine = 0u;
#pragma unroll
        for (unsigned j = 0; j < 16; ++j) { const unsigned c = xb_ld(&bar[XB_XCNT(j)]); sum += c; cnt += (c > 0u) ? 1u : 0u; mine = (j == x) ? c : mine; }
        if (sum == G) break;
        __builtin_amdgcn_s_sleep(1);
        if ((++sp & 255u) == 0u) { if (xb_ld(&bar[XB_TMO])) break; if (sp > XB_SPIN_CAP) { atomicAdd(&bar[XB_TMO], 1u); break; } }
    }
    nloc = mine > 0u ? mine : 1u; nx = cnt > 0u ? cnt : 1u;
}

__device__ __forceinline__ void xcd_barrier(const XcdBarrier& b) {
    asm volatile("s_waitcnt vmcnt(0)" ::: "memory");
    __syncthreads();
    if (threadIdx.x == 0) {
        unsigned* bar = b.bar;
        __builtin_amdgcn_s_waitcnt(0);
        unsigned nloc = b.st[0], nx = b.st[1];
        if (nloc == 0u) { xcd_barrier_complete(bar, b.x, nloc, nx); b.st[0] = nloc; b.st[1] = nx; }
        const unsigned old = xb_add(&bar[XB_XSUB(b.x)], 1u);
        const unsigned gen = old / nloc;
        if (old + 1u == (gen + 1u) * nloc) {
            __builtin_amdgcn_fence(__ATOMIC_RELEASE, "agent");
            asm volatile("s_waitcnt vmcnt(0)" ::: "memory");
            const unsigned og = xb_add(&bar[XB_TOP], 1u);
            const unsigned tg = og / nx;
            if (og + 1u == (tg + 1u) * nx) xb_add(&bar[XB_TOPGEN], 1u);
            else XB_SPIN(xb_ld(&bar[XB_TOPGEN]) == tg, bar);
            __builtin_amdgcn_fence(__ATOMIC_ACQUIRE, "agent");
            xb_add(&bar[XB_XGEN(b.x)], 1u);
            asm volatile("s_waitcnt vmcnt(0)" ::: "memory");
        } else {
            XB_SPIN(xb_ld(&bar[XB_XGEN(b.x)]) == gen, bar);
            __builtin_amdgcn_fence(__ATOMIC_ACQUIRE, "agent");
            asm volatile("s_waitcnt vmcnt(0)" ::: "memory");
        }
    }
    __syncthreads();
}

constexpr size_t WS_BAR = 3u << 20;
constexpr int BARGEN_OFF = 131072 + 512;
#define GRID_SYNC() xcd_barrier(xbar)
#define PHASE_IDS int t_o_ = threadIdx.x; asm volatile("" : "+v"(t_o_)); const int tid = t_o_, lane = tid & 63, wave = __builtin_amdgcn_readfirstlane(tid >> 6); const int gw = vcu * 8 + wave, gtid = bx * 512 + tid; (void)gw; (void)gtid; (void)lane; (void)wave;

struct Args { const float* in[34]; float* out; unsigned char* ws; };

__device__ __forceinline__ float wave_sum(float v) {
#pragma unroll
    for (int o = 1; o < 64; o <<= 1) v += __shfl_xor(v, o);
    return v;
}
__device__ __forceinline__ unsigned pk2(float lo, float hi) { return pg8::cvt_pk_bf16(lo, hi); }
__device__ __forceinline__ float bflo(unsigned w) { return (float)__builtin_bit_cast(pg8::f16x2, w)[0]; }
__device__ __forceinline__ float bfhi(unsigned w) { return (float)__builtin_bit_cast(pg8::f16x2, w)[1]; }


#ifdef DBG
#define DBG_OFF (WS_TAB + 65536)
#define DBG_SNAP (WS_TAB + 131072)
__device__ __forceinline__ void dbg_flag(unsigned char* ws, int bit) { atomicOr((unsigned*)(ws + DBG_OFF), 1u << bit); }
__device__ __forceinline__ bool dbg_bad(float got, float ref) { return !(fabsf(got - ref) <= 0.02f * fabsf(ref) + 0.02f); }
__device__ __forceinline__ unsigned hsh(unsigned x) { x ^= x >> 16; x *= 0x7feb352dU; x ^= x >> 15; x *= 0x846ca68bU; x ^= x >> 16; return x; }
__device__ __forceinline__ float h2f(const bf16* p) { return (float)*(const _Float16*)p; }
__device__ __forceinline__ float silu_x(float v) { return v / (1.0f + expf(-v)); }
#endif
enum { WK_IDENT = 0, WK_CONV_IN, WK_GU, WK_MLA_IN, WK_MLA_QUP, WK_MLA_KVUP, WK_PAIR64 };
__device__ __forceinline__ void conv_item(const float* W, int ldn, int K, int lcol, const float* gain, bf16* WT, int prow0, int k0, LAS float* scr, int lane) {
    if (lcol < 0) {
        const int c = lane & 7;
#pragma unroll
        for (int j = 0; j < 4; ++j) { const int n = (lane >> 3) + 8 * j; *(v4u*)(WT + (size_t)(prow0 + n) * K + k0 + 8 * c) = (v4u){0u, 0u, 0u, 0u}; }
        return;
    }
#pragma unroll 32
    for (int i = 0; i < 32; ++i) { const int kk = 2 * i + (lane >> 5); float v = W[(size_t)(k0 + kk) * ldn + lcol + (lane & 31)]; if (gain) v *= gain[k0 + kk]; scr[kk * 33 + (lane & 31)] = v; }
    asm volatile("s_waitcnt lgkmcnt(0)" ::: "memory");
    const int c = lane & 7;
#pragma unroll
    for (int j = 0; j < 4; ++j) { const int n = (lane >> 3) + 8 * j; const LAS float* s = scr + (8 * c) * 33 + n;
        v4u o; o.x = pk2(s[0 * 33], s[1 * 33]); o.y = pk2(s[2 * 33], s[3 * 33]); o.z = pk2(s[4 * 33], s[5 * 33]); o.w = pk2(s[6 * 33], s[7 * 33]);
        *(v4u*)(WT + (size_t)(prow0 + n) * K + k0 + 8 * c) = o; }
    asm volatile("s_waitcnt lgkmcnt(0)" ::: "memory");
}
__device__ __forceinline__ void conv_matrix_item(int kind, const float* s0, const float* s1, int ldn, int K, int Nphys, const float* gain, bf16* WT, int r, LAS float* scr, int lane) {
    const int ngr = Nphys / 32, kb = r / ngr, G = r % ngr; const int pn = G >> 3, bj = (G >> 2) & 1, wc = G & 3;
    const float* src = s0; int lcol = 32 * G;
    switch (kind) {
        case WK_CONV_IN: if (pn >= 4) lcol = (bj ? 2048 : 1024) + 128 * (pn - 4) + 32 * wc; break;
        case WK_GU: src = bj ? s1 : s0; lcol = 128 * pn + 32 * wc; break;
        case WK_MLA_IN: if (G >= 33) lcol = -1; break;
        case WK_MLA_QUP: lcol = pn < 4 ? (4 * pn + wc) * 96 + 32 * bj : (8 * (pn - 4) + 4 * bj + wc) * 96 + 64; break;
        case WK_MLA_KVUP: lcol = pn < 4 ? (4 * pn + wc) * 128 + 32 * bj : (4 * (pn - 4) + wc) * 128 + 64 + 32 * bj; break;
        case WK_PAIR64: lcol = 256 * pn + 64 * wc + 32 * bj; break;
        default: break;
    }
    conv_item(src, ldn, K, lcol, gain, WT, 32 * G, 64 * kb, scr, lane);
}
#define CONV_MAT(kind, s0, s1, ldn, K, Nphys, gain, dst) { const int ni_ = ((K) / 64) * ((Nphys) / 32); if (r < ni_) { conv_matrix_item(kind, s0, s1, ldn, K, Nphys, gain, dst, r, scr, lane); continue; } r -= ni_; }

template <int DQK, int DV, bool SPLIT> struct AttnP {
    const bf16* Q; int ldq;
    const bf16* K; int ldk;
    const bf16* Kpe;
    const bf16* V; int ldv;
    bf16* O;
    float lam, fin;
    const float* subg;
};
template <int DQK, int DV, bool SPLIT>
__device__ __forceinline__ void attn_unit(LAS unsigned char* lds, const AttnP<DQK, DV, SPLIT>& P, int b, int h, int qrow0, int ntiles_in) {
    constexpr int KW = SPLIT ? 128 : DQK;
    constexpr int KSTR = KW * 2 + 16, VSTR = 144;
    constexpr int KT = 64 * KSTR, VT = DV * VSTR, BUF = KT + VT;
    constexpr int NQ = DQK / 16, NDV = DV / 32;
    constexpr int NKC = SPLIT ? 2 : 1, NVC = DV / 64;
    int tid_o = threadIdx.x; asm volatile("" : "+v"(tid_o));
    const int tid = tid_o, lane = tid & 63, w = __builtin_amdgcn_readfirstlane(tid >> 6), l32 = lane & 31, hh = lane >> 5;
    const int stream = SPLIT ? (w >> 2) : 0;
    const int qrow = qrow0 + 32 * (SPLIT ? (w & 3) : w) + l32;
    int ntiles = ntiles_in; asm volatile("" : "+s"(ntiles));
    const int ctx0 = ML + b * CTXL, lat0 = b * SEQ;
    bf16x8 qf[NQ];
    { const bf16* qp = P.Q + (size_t)qrow * P.ldq + (SPLIT ? h * 128 + 64 * stream : h * DQK) + 8 * hh;
#pragma unroll
      for (int s = 0; s < NQ; ++s) qf[s] = *(const bf16x8*)(qp + 16 * s); }
    f32x16 o[NDV];
#pragma unroll
    for (int i = 0; i < NDV; ++i)
#pragma unroll
        for (int r = 0; r < 16; ++r) o[i][r] = 0.f;
    f32x16 negm;
    if constexpr (!SPLIT) {
#pragma unroll
    for (int r = 0; r < 16; ++r) negm[r] = -2.0f;
    } else {
#pragma unroll
    for (int r = 0; r < 16; ++r) negm[r] = 0.f;
    asm volatile("" : "+v"(negm));
    }
    float mrun = 0.f, lrun = 0.f;
    v4u kreg[2][NKC]; v4u kpreg[2]; v2u va[2][NVC], vb[2][NVC];
    const int vpr = tid & 31, vc4 = tid >> 5;
    const int vkey = ((2 * vpr) & ~12) | (((2 * vpr) >> 2) & 1) << 3 | (((2 * vpr) >> 3) & 1) << 2;
#define ATT_ROW0(t) (64 * (t) + (((t) < 4) ? ctx0 : lat0 - 256))
#define ATT_LOADK(t, S_) do { const int kr0_ = ATT_ROW0(t); \
        if (SPLIT) { _Pragma("unroll") for (int i_ = 0; i_ < NKC; ++i_) { const int idx_ = tid + 512 * i_; kreg[S_][i_] = *(const v4u*)(P.K + (size_t)(kr0_ + (idx_ >> 4)) * P.ldk + h * 128 + (idx_ & 15) * 8); } } \
        else { kreg[S_][0] = *(const v4u*)(P.K + (size_t)(kr0_ + (tid >> 3)) * P.ldk + h * 64 + (tid & 7) * 8); kpreg[S_] = *(const v4u*)(P.Kpe + (size_t)(kr0_ + ((tid & 255) >> 2)) * 32 + (tid & 3) * 8); } } while (0)
#define ATT_LOADV(t, S_) do { const int kr0_ = ATT_ROW0(t); \
        _Pragma("unroll") for (int i_ = 0; i_ < NVC; ++i_) { const bf16* vp_ = P.V + (size_t)(kr0_ + vkey) * P.ldv + h * DV + 4 * (vc4 + 16 * i_); va[S_][i_] = *(const v2u*)vp_; vb[S_][i_] = *(const v2u*)(vp_ + P.ldv); } } while (0)
#define ATT_STOREK(buf, S_) do { LAS unsigned char* kb_ = lds + (buf) * KT; \
        if (SPLIT) { _Pragma("unroll") for (int i_ = 0; i_ < NKC; ++i_) { const int idx_ = tid + 512 * i_; *(LAS v4u*)(kb_ + (idx_ >> 4) * KSTR + (idx_ & 15) * 16) = kreg[S_][i_]; } } \
        else { *(LAS v4u*)(kb_ + (tid >> 3) * KSTR + (tid & 7) * 16) = kreg[S_][0]; *(LAS v4u*)(kb_ + ((tid & 255) >> 2) * KSTR + 128 + (tid & 3) * 16) = kpreg[S_]; } } while (0)
#define ATT_STOREV(buf, S_) do { LAS unsigned char* vb_ = lds + 2 * KT + (buf) * VT; \
        _Pragma("unroll") for (int i_ = 0; i_ < NVC; ++i_) { LAS unsigned char* d_ = vb_ + (4 * (vc4 + 16 * i_)) * VSTR + vpr * 4; \
            *(LAS unsigned*)(d_) = (va[S_][i_].x & 0xffffu) | (vb[S_][i_].x << 16); *(LAS unsigned*)(d_ + VSTR) = (va[S_][i_].x >> 16) | (vb[S_][i_].x & 0xffff0000u); \
            *(LAS unsigned*)(d_ + 2 * VSTR) = (va[S_][i_].y & 0xffffu) | (vb[S_][i_].y << 16); *(LAS unsigned*)(d_ + 3 * VSTR) = (va[S_][i_].y >> 16) | (vb[S_][i_].y & 0xffff0000u); } } while (0)
#define ATT_QK(dst, buf) do { const LAS unsigned char* kb_ = lds + (buf) * KT; bf16x8 kf_[2][NQ]; \
        _Pragma("unroll") for (int kk = 0; kk < 2; ++kk) { const LAS unsigned char* kp = kb_ + (32 * kk + l32) * KSTR + (SPLIT ? 128 * stream : 0) + 16 * hh; \
            _Pragma("unroll") for (int q = 0; q < NQ; ++q) kf_[kk][q] = *(const LAS bf16x8*)(kp + 32 * q); } \
        __builtin_amdgcn_sched_barrier(0);     \
        _Pragma("unroll") for (int kk = 0; kk < 2; ++kk) dst[kk] = __builtin_amdgcn_mfma_f32_32x32x16_f16(__builtin_bit_cast(pg8::f16x8, kf_[kk][0]), __builtin_bit_cast(pg8::f16x8, qf[0]), negm, 0, 0, 0); \
        _Pragma("unroll") for (int q = 1; q < NQ; ++q) { _Pragma("unroll") for (int kk = 0; kk < 2; ++kk) \
            dst[kk] = __builtin_amdgcn_mfma_f32_32x32x16_f16(__builtin_bit_cast(pg8::f16x8, kf_[kk][q]), __builtin_bit_cast(pg8::f16x8, qf[q]), dst[kk], 0, 0, 0); } \
        __builtin_amdgcn_sched_barrier(0); } while (0)
    constexpr float THR = 10.0f;
    f32x16 s[2];
    ATT_LOADK(0, 0); ATT_LOADV(0, 0); ATT_LOADK(1, 1); ATT_LOADV(1, 1);
    ATT_STOREK(0, 0); ATT_STOREV(0, 0);
    asm volatile("s_waitcnt lgkmcnt(0)\n\ts_barrier" ::: "memory");
    if (w >= 4) asm volatile("s_barrier" ::: "memory");
    for (int t0 = 0; t0 < ntiles; t0 += 2) {
#pragma unroll
      for (int u2 = 0; u2 < 2; ++u2) {
        const int t = t0 + u2;
        { const int tl_ = (t + 2 < ntiles) ? t + 2 : ntiles - 1; ATT_LOADK(tl_, u2); ATT_LOADV(tl_, u2); }
        ATT_QK(s, u2);
        if constexpr (SPLIT) {
        float mxa = __builtin_fmaxf(__builtin_fmaxf(s[0][0], s[0][1]), s[1][0]), mxb = __builtin_fmaxf(__builtin_fmaxf(s[0][2], s[0][3]), s[1][1]); mxa = __builtin_fmaxf(__builtin_fmaxf(mxa, s[1][2]), s[1][3]);
#pragma unroll
        for (int r = 4; r < 16; r += 4) { mxa = __builtin_fmaxf(__builtin_fmaxf(mxa, s[0][r]), s[0][r + 1]); mxb = __builtin_fmaxf(__builtin_fmaxf(mxb, s[0][r + 2]), s[0][r + 3]);
            mxa = __builtin_fmaxf(__builtin_fmaxf(mxa, s[1][r]), s[1][r + 1]); mxb = __builtin_fmaxf(__builtin_fmaxf(mxb, s[1][r + 2]), s[1][r + 3]); }
        float mx = __builtin_fmaxf(mxa, mxb);
        mx = fmaxf(mx, pg8::lanex(mx, lane, 32));
        if (t == 0 || __any(mx > THR)) {
            const float delta = (t == 0) ? mx : fmaxf(mx, 0.f); const float alpha = (t == 0) ? 0.f : __builtin_amdgcn_exp2f(-delta); mrun += delta; lrun *= alpha;
#pragma unroll
            for (int i = 0; i < NDV; ++i)
#pragma unroll
                for (int r = 0; r < 16; ++r) o[i][r] *= alpha;
#pragma unroll
            for (int kk = 0; kk < 2; ++kk)
#pragma unroll
                for (int r = 0; r < 16; ++r) s[kk][r] -= delta;
#pragma unroll
            for (int r = 0; r < 16; ++r) negm[r] = -mrun;
            asm volatile("" : "+v"(negm));
        }
        }
        ATT_STOREK((u2 ^ 1), (u2 ^ 1));
        asm volatile("s_waitcnt lgkmcnt(0)\n\ts_barrier" ::: "memory");
        float ps = 0.f, ps2 = 0.f;
#pragma unroll
        for (int kk = 0; kk < 2; ++kk)
#pragma unroll
            for (int r = 0; r < 16; r += 2) { s[kk][r] = __builtin_amdgcn_exp2f(s[kk][r]); s[kk][r + 1] = __builtin_amdgcn_exp2f(s[kk][r + 1]); ps += s[kk][r]; ps2 += s[kk][r + 1]; }
        lrun += ps + ps2;
        bf16x8 pf[2][2];
#pragma unroll
        for (int kk = 0; kk < 2; ++kk)
#pragma unroll
            for (int ss = 0; ss < 2; ++ss) { v4u wv; wv.x = pg8::cvt_pk_bf16(s[kk][8 * ss + 0], s[kk][8 * ss + 1]); wv.y = pg8::cvt_pk_bf16(s[kk][8 * ss + 2], s[kk][8 * ss + 3]);
                wv.z = pg8::cvt_pk_bf16(s[kk][8 * ss + 4], s[kk][8 * ss + 5]); wv.w = pg8::cvt_pk_bf16(s[kk][8 * ss + 6], s[kk][8 * ss + 7]); pf[kk][ss] = __builtin_bit_cast(bf16x8, wv); }
        { const LAS unsigned char* vbp = lds + 2 * KT + u2 * VT;
#pragma unroll
          for (int i = 0; i < NDV; i += 2) {
            bf16x8 vf[2][4];
#pragma unroll
            for (int j = 0; j < 2; ++j) { const LAS unsigned char* vp = vbp + (32 * (i + j) + l32) * VSTR + 16 * hh;
#pragma unroll
                for (int c = 0; c < 4; ++c) vf[j][c] = *(const LAS bf16x8*)(vp + 32 * c); }
            __builtin_amdgcn_sched_barrier(0);
#pragma unroll
            for (int c = 0; c < 4; ++c)
#pragma unroll
                for (int j = 0; j < 2; ++j) o[i + j] = __builtin_amdgcn_mfma_f32_32x32x16_f16(__builtin_bit_cast(pg8::f16x8, vf[j][c]), __builtin_bit_cast(pg8::f16x8, pf[c >> 1][c & 1]), o[i + j], 0, 0, 0);
            __builtin_amdgcn_sched_barrier(0);
          } }
        ATT_STOREV((u2 ^ 1), (u2 ^ 1));
        asm volatile("s_waitcnt lgkmcnt(0)\n\ts_barrier" ::: "memory");
      }
    }
    if (w < 4) asm volatile("s_barrier" ::: "memory");
#undef ATT_ROW0
#undef ATT_LOADK
#undef ATT_LOADV
#undef ATT_STOREK
#undef ATT_STOREV
#undef ATT_QK
    const float ltot = lrun + pg8::lanex(lrun, lane, 32);
    const float linv = 1.0f / ltot;
    if (!SPLIT) {
        bf16* op = P.O + (size_t)qrow * 1024 + h * DV + 4 * hh;
#pragma unroll
        for (int i = 0; i < NDV; ++i)
#pragma unroll
            for (int g = 0; g < 4; ++g) { v2u wv; wv.x = pg8::cvt_pk_bf16(o[i][4 * g] * linv, o[i][4 * g + 1] * linv); wv.y = pg8::cvt_pk_bf16(o[i][4 * g + 2] * linv, o[i][4 * g + 3] * linv);
                *(v2u*)(op + 32 * i + 8 * g) = wv; }
    } else {
        LAS f32x4* X = (LAS f32x4*)lds;
        if (w >= 4) {
#pragma unroll
            for (int i = 0; i < NDV; ++i)
#pragma unroll
                for (int g = 0; g < 4; ++g) X[(((w & 3) * 16 + i * 4 + g) * 64) + lane] = (f32x4){o[i][4 * g] * linv, o[i][4 * g + 1] * linv, o[i][4 * g + 2] * linv, o[i][4 * g + 3] * linv};
        }
        __syncthreads();
        if (w < 4) {
            float ss = 0.f;
#pragma unroll
            for (int i = 0; i < NDV; ++i)
#pragma unroll
                for (int g = 0; g < 4; ++g) { const f32x4 x2 = X[((w * 16 + i * 4 + g) * 64) + lane];
#pragma unroll
                    for (int e = 0; e < 4; ++e) { const float c = o[i][4 * g + e] * linv - P.lam * x2[e]; o[i][4 * g + e] = c; ss += c * c; } }
            ss += pg8::lanex(ss, lane, 32);
            const float rn = rsqrtf(ss * (1.0f / 128.0f) + EPS) * P.fin;
            bf16* op = P.O + (size_t)qrow * 1024 + h * DV + 4 * hh;
#pragma unroll
            for (int i = 0; i < NDV; ++i)
#pragma unroll
                for (int g = 0; g < 4; ++g) { const f32x4 gg = *(const f32x4*)(P.subg + 32 * i + 8 * g + 4 * hh);
                    v2u wv; wv.x = pg8::cvt_pk_bf16(o[i][4 * g] * rn * gg[0], o[i][4 * g + 1] * rn * gg[1]); wv.y = pg8::cvt_pk_bf16(o[i][4 * g + 2] * rn * gg[2], o[i][4 * g + 3] * rn * gg[3]);
                    *(v2u*)(op + 32 * i + 8 * g) = wv; }
        }
        __syncthreads();
    }
}

constexpr int PTAB_OFF = 131072 + 1024;
enum { I_X = 0, I_C, I_CTX, I_CCTX, I_NMG, I_NFG, I_MODW, I_MODB, I_FWG, I_FWU, I_FWD, I_CWIN, I_CK, I_CB, I_CWOUT, I_MWIN, I_MQNG, I_MWQUP, I_MKVNG, I_MWKVUP,
       I_MQNN, I_MQNR, I_MKNN, I_MKNR, I_MWOUT, I_DWIN, I_DQNG, I_DKNG, I_DLQ1, I_DLK1, I_DLQ2, I_DLK2, I_DSUBG, I_DWOUT, I_OUT, I_WS };
typedef __attribute__((address_space(4))) const unsigned long long* kptr_t;
__device__ __forceinline__ unsigned long long ptab_get(LAS unsigned char* lds, int i) {
    (void)lds; kptr_t ka = (kptr_t)__builtin_amdgcn_kernarg_segment_ptr(); asm volatile("" : "+s"(ka)); return ka[i];
}
#define GASP __attribute__((address_space(1)))
#define PF(i) ((const float*)(GASP const float*)ptab_get(lds, (i)))
#define PWS() ((unsigned char*)(GASP unsigned char*)ptab_get(lds, I_WS))
#define POUT() ((float*)(GASP float*)ptab_get(lds, I_OUT))

#ifndef KNOCK
#define KNOCK 0
#endif
#define GEMM_PHASE(ID_, EpiT, Aptr, lda_, Bptr, Mrows, Ncols, Kdim, ...) do { if constexpr (!((KNOCK >> (ID_)) & 1)) { pg8::Gemm g_{(const pg8::bf16_t*)(Aptr), (const pg8::bf16_t*)(Bptr), (Mrows), (Ncols), (Kdim), (lda_)}; pg8::StaticOrder S_; S_.init((Mrows), (Ncols), G, ((ID_) == 3 ? (bx + 192) % G : bx)); \
        EpiT E_{__VA_ARGS__}; pg8::gemm_phase<EpiT, pg8::StaticOrder, true, true>(lds, g_, S_, E_); } } while (0)
#define WSP(T, off) ((T*)(PWS() + (off)))
#define NORM_ROWS(hl, hc, gvec, shoff, scoff, Mr) do { PHASE_IDS const float* hl_ = (hl); const float* hc_ = (hc); const float* gv_ = (gvec); const float* modL_ = WSP(float, WS_MOD) + (size_t)L * 9 * 6144; bf16* XN_ = WSP(bf16, WS_XN); \
            for (int row0_ = gw; row0_ < (Mr); row0_ += 2 * NGW) { const int row1_ = row0_ + NGW; const bool has1_ = row1_ < (Mr); const int rowb_ = has1_ ? row1_ : row0_;     \
                const bool isc0 = row0_ >= ML, isc1 = rowb_ >= ML; const float* hr0 = isc0 ? hc_ + (size_t)(row0_ - ML) * D : hl_ + (size_t)row0_ * D; const float* hr1 = isc1 ? hc_ + (size_t)(rowb_ - ML) * D : hl_ + (size_t)rowb_ * D; \
                const f32x4* xr0 = (const f32x4*)hr0 + lane; const f32x4* xr1 = (const f32x4*)hr1 + lane; f32x4 v0[4], v1[4]; float s0 = 0.f, s1 = 0.f; \
                _Pragma("unroll") for (int j = 0; j < 4; ++j) { v0[j] = xr0[64 * j]; v1[j] = xr1[64 * j]; } \
                _Pragma("unroll") for (int j = 0; j < 4; ++j) { s0 += (v0[j].x * v0[j].x + v0[j].y * v0[j].y) + (v0[j].z * v0[j].z + v0[j].w * v0[j].w); s1 += (v1[j].x * v1[j].x + v1[j].y * v1[j].y) + (v1[j].z * v1[j].z + v1[j].w * v1[j].w); } \
                _Pragma("unroll") for (int o_ = 1; o_ < 64; o_ <<= 1) { s0 += __shfl_xor(s0, o_); s1 += __shfl_xor(s1, o_); } \
                const float rstd0 = rsqrtf(s0 * (1.0f / D) + EPS), rstd1 = rsqrtf(s1 * (1.0f / D) + EPS); const int mi0 = isc0 ? 8 : (row0_ >> 12), mi1 = isc1 ? 8 : (rowb_ >> 12); \
                const f32x4* gr = (const f32x4*)gv_ + lane; \
                const f32x4* sh0 = (const f32x4*)(modL_ + mi0 * 6144 + (shoff)) + lane; const f32x4* sc0 = (const f32x4*)(modL_ + mi0 * 6144 + (scoff)) + lane; \
                const f32x4* sh1 = (const f32x4*)(modL_ + mi1 * 6144 + (shoff)) + lane; const f32x4* sc1 = (const f32x4*)(modL_ + mi1 * 6144 + (scoff)) + lane; \
                unsigned long long* o80 = (unsigned long long*)(XN_ + (size_t)row0_ * D) + lane; unsigned long long* o81 = (unsigned long long*)(XN_ + (size_t)rowb_ * D) + lane; \
                _Pragma("unroll") for (int j = 0; j < 4; ++j) { const f32x4 gg = gr[64 * j]; const f32x4 y0 = v0[j] * rstd0 * gg * (sc0[64 * j] + 1.0f) + sh0[64 * j]; \
                    o80[64 * j] = (unsigned long long)pk2(y0.x, y0.y) | ((unsigned long long)pk2(y0.z, y0.w) << 32); \
                    if (has1_) { const f32x4 y1 = v1[j] * rstd1 * gg * (sc1[64 * j] + 1.0f) + sh1[64 * j]; o81[64 * j] = (unsigned long long)pk2(y1.x, y1.y) | ((unsigned long long)pk2(y1.z, y1.w) << 32); } } } } while (0)
template <int LL, int PART, int SKIP = 0> __device__ __forceinline__ void convert_weights(LAS unsigned char* lds, const int G, const int bx, const int vcu) {
    constexpr int kind = LL % 3, slot = LL / 3; const int NGW = (G - SKIP) * 8;
    if (bx < SKIP) return;
    PHASE_IDS
    unsigned char* ws = PWS();
    bf16* W_in = (bf16*)(ws + WS_W + W_IN); bf16* W_b = (bf16*)(ws + WS_W + W_B); bf16* W_c = (bf16*)(ws + WS_W + W_C); bf16* W_out = (bf16*)(ws + WS_W + W_OUT); bf16* W_gu = (bf16*)(ws + WS_W + W_GU); bf16* W_dn = (bf16*)(ws + WS_W + W_DN);
    (void)W_b; (void)W_c;
    LAS float* scr = (LAS float*)(lds + wave * 16384);
    const float* fg = PF(I_FWG) + (size_t)LL * D * FF; const float* fu = PF(I_FWU) + (size_t)LL * D * FF; const float* fd = PF(I_FWD) + (size_t)LL * FF * D;
    int total = 0;
    if (PART != 2) { total += (D / 64) * (2 * FF / 32);
        if (kind == 0) total += (D / 64) * (3072 / 32) + (D / 64) * (D / 32);
        else if (kind == 1) total += (D / 64) * (1280 / 32) + (768 / 64) * (1536 / 32) + (256 / 64) * (2048 / 32) + (D / 64) * (D / 32);
        else total += (D / 64) * (3072 / 32) + (D / 64) * (D / 32); }
    if (PART != 1) total += (FF / 64) * (D / 32);
    for (int it = (bx - SKIP) * 8 + wave; it < total; it += NGW) {
        int r = it;
        if (PART != 1) { CONV_MAT(WK_IDENT, fd, fd, D, FF, D, nullptr, W_dn) }
        if (PART != 2) {
            CONV_MAT(WK_GU, fg, fu, FF, D, 2 * FF, nullptr, W_gu)
            if (kind == 0) {
                CONV_MAT(WK_CONV_IN, PF(I_CWIN) + (size_t)slot * D * 3072, nullptr, 3072, D, 3072, nullptr, W_in)
                CONV_MAT(WK_IDENT, PF(I_CWOUT) + (size_t)slot * D * D, nullptr, D, D, D, nullptr, W_out)
            } else if (kind == 1) {
                CONV_MAT(WK_MLA_IN, PF(I_MWIN), nullptr, 1056, D, 1280, nullptr, W_in)
                CONV_MAT(WK_MLA_QUP, PF(I_MWQUP), nullptr, 1536, 768, 1536, PF(I_MQNG), W_b)
                CONV_MAT(WK_MLA_KVUP, PF(I_MWKVUP), nullptr, 2048, 256, 2048, PF(I_MKVNG), W_c)
                CONV_MAT(WK_IDENT, PF(I_MWOUT), nullptr, D, D, D, nullptr, W_out)
            } else {
                CONV_MAT(WK_PAIR64, PF(I_DWIN), nullptr, 3072, D, 3072, nullptr, W_in)
                CONV_MAT(WK_IDENT, PF(I_DWOUT), nullptr, D, D, D, nullptr, W_out)
            }
        }
    }
}
template <int L> __device__ __forceinline__ void layer_fn(LAS unsigned char* lds, const int G, const int bx, const int vcu, const XcdBarrier& xbar) {
    const int NGW = G * 8, GS = G * 512;
    {
        constexpr int kind = L % 3, slot = L / 3; constexpr bool last = (L == 3);
        constexpr int Mrows = last ? ML : MT;
        constexpr int Mffn = (L >= 2) ? ML : MT;
        if constexpr (L > 0) convert_weights<L, 2>(lds, G, bx, vcu);
        NORM_ROWS((L == 0) ? PF(I_X) : (const float*)POUT(), (L == 0) ? PF(I_CTX) : WSP(const float, WS_HCTX), PF(I_NMG) + L * D, 0, 1024, Mrows);
        GRID_SYNC();
#ifdef DBG
        if constexpr (L == 0) { PHASE_IDS unsigned char* ws = PWS(); const unsigned sidx = (unsigned)gtid;
            { const int l = sidx & 3, j = (sidx >> 2) % 9, n = hsh(sidx) % 6144; const float* cv = j < 8 ? PF(I_C) + j * 1024 : PF(I_CCTX); const float* mw = PF(I_MODW) + (size_t)l * 1024 * 6144 + n;
              float ref = PF(I_MODB)[l * 6144 + n]; for (int k = 0; k < 1024; ++k) ref += silu_x(cv[k]) * mw[(size_t)k * 6144];
              if (dbg_bad(WSP(float, WS_MOD)[(size_t)(l * 9 + j) * 6144 + n], ref)) dbg_flag(ws, 0); }
            { const int row = hsh(sidx + 11u) % MT, col = hsh(sidx + 7777u) % 1024; const bool isc = row >= ML; const float* hr = isc ? PF(I_CTX) + (size_t)(row - ML) * D : PF(I_X) + (size_t)row * D; const int mi = isc ? 8 : (row >> 12);
              float ss = 0.f; for (int k = 0; k < 1024; ++k) ss += hr[k] * hr[k]; const float rstd = 1.0f / sqrtf(ss / 1024.0f + 1e-6f); const float* md = WSP(float, WS_MOD) + mi * 6144;
              const float ref = hr[col] * rstd * PF(I_NMG)[col] * (1.0f + md[1024 + col]) + md[col];
              if (dbg_bad(h2f(WSP(bf16, WS_XN) + (size_t)row * D + col), ref)) dbg_flag(ws, 1); } }
        GRID_SYNC();
#endif
        if constexpr (kind == 0) {
            GEMM_PHASE(0, pg8::EpiPair<0>, WSP(bf16, WS_XN), D, WSP(bf16, WS_W + W_IN), Mrows, 3072, D, WSP(bf16, WS_BIG));
            GRID_SYNC();
#ifdef DBG
            if constexpr (L == 0) { PHASE_IDS unsigned char* ws = PWS(); const unsigned sidx = (unsigned)gtid; const int row = hsh(sidx + 5u) % MT, col = hsh(sidx * 3u + 1u) % 1024;
                const bf16* xr = WSP(bf16, WS_XN) + (size_t)row * D; const float* w = PF(I_CWIN) + col; float b = 0.f, c = 0.f, u = 0.f;
                for (int k = 0; k < 1024; ++k) { const float a = h2f(xr + k); b += a * w[(size_t)k * 3072]; c += a * w[(size_t)k * 3072 + 1024]; u += a * w[(size_t)k * 3072 + 2048]; }
                const bf16* pr = WSP(bf16, WS_BIG) + (size_t)row * 2048;
                if (dbg_bad(h2f(pr + col), b) || dbg_bad(h2f(pr + 1024 + col), c * u)) dbg_flag(ws, 2); }
        GRID_SYNC();
#endif
            { PHASE_IDS const float* ck = PF(I_CK) + (size_t)slot * 3 * D; const float* cb = PF(I_CB) + (size_t)slot * D; const bf16* BIG = WSP(bf16, WS_BIG); bf16* XN = WSP(bf16, WS_XN);
              for (int idx = gtid; idx < Mrows * 128; idx += GS) { const int row = idx >> 7, c8 = (idx & 127) * 8;
                  const bool isc = row >= ML; const int t = isc ? ((row - ML) & 255) : (row & 4095); const int tmax = isc ? 255 : 4095;
                  const bf16* pr = BIG + (size_t)row * 2048 + c8;
                  const v4u bb = *(const v4u*)pr; const v4u z0 = *(const v4u*)(pr + 1024);
                  v4u zm = (v4u){0u, 0u, 0u, 0u}, zp = zm; if (t > 0) zm = *(const v4u*)(pr + 1024 - 2048); if (t < tmax) zp = *(const v4u*)(pr + 1024 + 2048);
                  const f32x4 k0a = *(const f32x4*)(ck + c8), k0b = *(const f32x4*)(ck + c8 + 4), k1a = *(const f32x4*)(ck + D + c8), k1b = *(const f32x4*)(ck + D + c8 + 4), k2a = *(const f32x4*)(ck + 2 * D + c8), k2b = *(const f32x4*)(ck + 2 * D + c8 + 4);
                  const f32x4 cba = *(const f32x4*)(cb + c8), cbb = *(const f32x4*)(cb + c8 + 4);
                  v4u ov;
                  { float y0, y1;
                    y0 = bflo(bb.x) * (k0a[0] * bflo(zm.x) + k1a[0] * bflo(z0.x) + k2a[0] * bflo(zp.x) + cba[0]); y1 = bfhi(bb.x) * (k0a[1] * bfhi(zm.x) + k1a[1] * bfhi(z0.x) + k2a[1] * bfhi(zp.x) + cba[1]); ov.x = pk2(y0, y1);
                    y0 = bflo(bb.y) * (k0a[2] * bflo(zm.y) + k1a[2] * bflo(z0.y) + k2a[2] * bflo(zp.y) + cba[2]); y1 = bfhi(bb.y) * (k0a[3] * bfhi(zm.y) + k1a[3] * bfhi(z0.y) + k2a[3] * bfhi(zp.y) + cba[3]); ov.y = pk2(y0, y1);
                    y0 = bflo(bb.z) * (k0b[0] * bflo(zm.z) + k1b[0] * bflo(z0.z) + k2b[0] * bflo(zp.z) + cbb[0]); y1 = bfhi(bb.z) * (k0b[1] * bfhi(zm.z) + k1b[1] * bfhi(z0.z) + k2b[1] * bfhi(zp.z) + cbb[1]); ov.z = pk2(y0, y1);
                    y0 = bflo(bb.w) * (k0b[2] * bflo(zm.w) + k1b[2] * bflo(z0.w) + k2b[2] * bflo(zp.w) + cbb[2]); y1 = bfhi(bb.w) * (k0b[3] * bfhi(zm.w) + k1b[3] * bfhi(z0.w) + k2b[3] * bfhi(zp.w) + cbb[3]); ov.w = pk2(y0, y1); }
                  *(v4u*)(XN + (size_t)row * D + c8) = ov; } }
            GRID_SYNC();
#ifdef DBG
            if constexpr (L == 0) { PHASE_IDS unsigned char* ws = PWS(); const unsigned sidx = (unsigned)gtid; const int row = hsh(sidx + 9u) % MT, col = hsh(sidx * 5u + 2u) % 1024;
                const bool isc = row >= ML; const int t = isc ? ((row - ML) & 255) : (row & 4095); const int tmax = isc ? 255 : 4095; const bf16* pr = WSP(bf16, WS_BIG) + (size_t)row * 2048;
                const float* ck = PF(I_CK); float y = PF(I_CB)[col] + ck[D + col] * h2f(pr + 1024 + col); if (t > 0) y += ck[col] * h2f(pr - 2048 + 1024 + col); if (t < tmax) y += ck[2 * D + col] * h2f(pr + 2048 + 1024 + col);
                if (dbg_bad(h2f(WSP(bf16, WS_XN) + (size_t)row * D + col), h2f(pr + col) * y)) dbg_flag(ws, 3); }
        GRID_SYNC();
#endif
        } else if constexpr (kind == 1) {
            GEMM_PHASE(1, pg8::EpiMlaIn, WSP(bf16, WS_XN), D, WSP(bf16, WS_W + W_IN), MT, 1280, D, WSP(bf16, WS_BIG), WSP(bf16, WS_BIG + BIG_KVL), WSP(bf16, WS_BIG + BIG_KPR), WSP(float, WS_ROWSS));
            GRID_SYNC();
            GEMM_PHASE(2, pg8::EpiMlaQ, WSP(bf16, WS_BIG), 768, WSP(bf16, WS_W + W_B), MT, 1536, 768, WSP(bf16, WS_BIG + BIG_Q), WSP(float, WS_ROWSS), PF(I_MQNN), PF(I_MQNR), WSP(float, WS_TAB), rsqrtf(96.0f) * LOG2E);
            GEMM_PHASE(3, pg8::EpiMlaKV, WSP(bf16, WS_BIG + BIG_KVL), 256, WSP(bf16, WS_W + W_C), MT, 2048, 256, WSP(bf16, WS_KV), WSP(bf16, WS_KV) + (size_t)MT * 1024, WSP(float, WS_ROWSS) + 3 * MT, PF(I_MKNN));
            if constexpr (!((KNOCK >> 12) & 1)) { PHASE_IDS const bf16* KPR = WSP(bf16, WS_BIG + BIG_KPR); bf16* KPE = WSP(bf16, WS_KPE); const float* tabM = WSP(float, WS_TAB); const float* kg = PF(I_MKNR);
              for (int row = gtid; row < MT; row += GS) {
                const v4u* src = (const v4u*)(KPR + (size_t)row * 32);
                float v[32];
#pragma unroll
                for (int q = 0; q < 4; ++q) { const v4u wv = src[q]; v[8 * q] = bflo(wv.x); v[8 * q + 1] = bfhi(wv.x); v[8 * q + 2] = bflo(wv.y); v[8 * q + 3] = bfhi(wv.y); v[8 * q + 4] = bflo(wv.z); v[8 * q + 5] = bfhi(wv.z); v[8 * q + 6] = bflo(wv.w); v[8 * q + 7] = bfhi(wv.w); }
                float ss = 0.f;
#pragma unroll
                for (int j = 0; j < 32; ++j) ss += v[j] * v[j];
                const float inv = rsqrtf(ss * (1.0f / 32.0f) + EPS);
#pragma unroll
                for (int j = 0; j < 32; ++j) v[j] = v[j] * inv * kg[j];
                if (row < ML) { const int t = row & 4095;
#pragma unroll
                    for (int hf = 0; hf < 2; ++hf) { const int pos = hf ? (t & 63) : (t >> 6);
#pragma unroll
                        for (int i = 0; i < 8; ++i) { const float c = tabM[pos * 8 + i], sn = tabM[512 + pos * 8 + i]; const float a = v[16 * hf + i], bq = v[16 * hf + 8 + i];
                            v[16 * hf + i] = a * c - bq * sn; v[16 * hf + 8 + i] = bq * c + a * sn; } } }
                v4u* dst = (v4u*)(KPE + (size_t)row * 32);
#pragma unroll
                for (int q = 0; q < 4; ++q) { v4u wv; wv.x = pk2(v[8 * q], v[8 * q + 1]); wv.y = pk2(v[8 * q + 2], v[8 * q + 3]); wv.z = pk2(v[8 * q + 4], v[8 * q + 5]); wv.w = pk2(v[8 * q + 6], v[8 * q + 7]); dst[q] = wv; } } }
            GRID_SYNC();
#ifdef DBG
            { PHASE_IDS unsigned char* ws = PWS(); const unsigned sidx = (unsigned)gtid; unsigned short* sn = (unsigned short*)(ws + DBG_SNAP);
              const int row = (sidx & 1) ? ML + (int)(hsh(sidx + 41u) % MC) : (int)(hsh(sidx + 41u) % ML); const int col = hsh(sidx + 43u) % 1024;
              sn[sidx * 4 + 0] = WSP(bf16, WS_KV)[(size_t)row * 1024 + col]; sn[sidx * 4 + 1] = (WSP(bf16, WS_KV) + (size_t)MT * 1024)[(size_t)row * 1024 + col];
              sn[sidx * 4 + 2] = WSP(bf16, WS_KPE)[(size_t)row * 32 + (col & 31)]; sn[sidx * 4 + 3] = WSP(bf16, WS_BIG + BIG_Q)[(size_t)row * 1536 + col]; }
#endif
            if constexpr (!((KNOCK >> 10) & 1)) { AttnP<96, 64, false> P{WSP(bf16, WS_BIG + BIG_Q), 1536, WSP(bf16, WS_KV), 1024, WSP(bf16, WS_KPE), WSP(bf16, WS_KV) + (size_t)MT * 1024, 1024, WSP(bf16, WS_XN), 0.f, 0.f, (const float*)(PWS() + WS_TAB + 262144)};
              for (int rep_ = 0; rep_ < ATT_REP; ++rep_)
              for (int u = vcu; u < 2048 + 128; u += G) {
                  const bool cq = u >= 2048; const int bh = cq ? u - 2048 : (u >> 4); const int bb = bh >> 4, hh_ = bh & 15; const int qrow0 = cq ? ML + bb * CTXL : bb * SEQ + (u & 15) * 256;
                  attn_unit<96, 64, false>(lds, P, bb, hh_, qrow0, cq ? 4 : 68); } }
            GRID_SYNC();
#ifdef DBG
            { PHASE_IDS unsigned char* ws = PWS(); const unsigned sidx = (unsigned)gtid;
              if (sidx < 32u) { const int q = sidx; const float* dmp = (const float*)(ws + WS_TAB + 262144); float m = -1e30f;
                for (int tt = 0; tt < 4; ++tt) for (int key = 0; key < 64; ++key) m = fmaxf(m, dmp[tt * 2048 + q * 64 + key]);
                float l = 0.f, l0 = 0.f; for (int tt = 0; tt < 4; ++tt) for (int key = 0; key < 64; ++key) { const float p = exp2f(dmp[tt * 2048 + q * 64 + key] - m); l += p; if (((key >> 2) & 1) == 0) l0 += p; }
                const float kl = dmp[4 * 2048 + q], km = dmp[4 * 2048 + 32 + q], kl0 = dmp[4 * 2048 + 64 + q]; unsigned* cw = (unsigned*)(ws + DBG_OFF) + 16;
                if (fabsf(kl - l) > 0.01f * l) atomicAdd(cw + 0, 1u); if (fabsf(km - m) > 0.01f) atomicAdd(cw + 1, 1u); if (fabsf(kl0 - l0) > 0.01f * l0) atomicAdd(cw + 2, 1u); if (fabsf(kl - 2.0f * kl0) < 0.001f * kl) atomicAdd(cw + 3, 1u); }
              { unsigned short* sn = (unsigned short*)(ws + DBG_SNAP); const int row = (sidx & 1) ? ML + (int)(hsh(sidx + 41u) % MC) : (int)(hsh(sidx + 41u) % ML); const int col = hsh(sidx + 43u) % 1024; unsigned* cw = (unsigned*)(ws + DBG_OFF) + 8;
                if (sn[sidx * 4 + 0] != WSP(bf16, WS_KV)[(size_t)row * 1024 + col]) atomicAdd(cw + 0, 1u);
                if (sn[sidx * 4 + 1] != (WSP(bf16, WS_KV) + (size_t)MT * 1024)[(size_t)row * 1024 + col]) atomicAdd(cw + 1, 1u);
                if (sn[sidx * 4 + 2] != WSP(bf16, WS_KPE)[(size_t)row * 32 + (col & 31)]) atomicAdd(cw + 2, 1u);
                if (sn[sidx * 4 + 3] != WSP(bf16, WS_BIG + BIG_Q)[(size_t)row * 1536 + col]) atomicAdd(cw + 3, 1u);
                if ((sidx & 1) && (sn[sidx * 4 + 0] != WSP(bf16, WS_KV)[(size_t)row * 1024 + col] || sn[sidx * 4 + 1] != (WSP(bf16, WS_KV) + (size_t)MT * 1024)[(size_t)row * 1024 + col])) atomicAdd(cw + 4, 1u); }
            }
        GRID_SYNC();
#endif
        } else {
            GEMM_PHASE(4, pg8::EpiDiff, WSP(bf16, WS_XN), D, WSP(bf16, WS_W + W_IN), MT, 3072, D, WSP(bf16, WS_BIG), PF(I_DQNG), PF(I_DKNG), WSP(float, WS_TAB) + 1024, 0.125f * LOG2E);
            GRID_SYNC();
            if constexpr (!((KNOCK >> 11) & 1)) { float lam; { PHASE_IDS const float d1 = wave_sum(PF(I_DLQ1)[lane] * PF(I_DLK1)[lane]), d2 = wave_sum(PF(I_DLQ2)[lane] * PF(I_DLK2)[lane]); lam = __expf(d1) - __expf(d2); }
              const float lam_init = 0.8f - 0.6f * 0.5488116360940264f;
              lam = __builtin_bit_cast(float, __builtin_amdgcn_readfirstlane(__builtin_bit_cast(int, lam))) + lam_init;
              bf16* BIG = WSP(bf16, WS_BIG);
              AttnP<64, 128, true> P{BIG, 3072, BIG + 1024, 3072, nullptr, BIG + 2048, 3072, WSP(bf16, WS_XN), lam, 1.0f - lam_init, PF(I_DSUBG)};
              for (int rep_ = 0; rep_ < ATT_REP; ++rep_)
              for (int u = vcu; u < 2048; u += G) { const int bh = u >> 5, qb = u & 31; attn_unit<64, 128, true>(lds, P, bh >> 3, bh & 7, (bh >> 3) * SEQ + qb * 128, 68); } }
            GRID_SYNC();
        }
        GEMM_PHASE(5, pg8::EpiResid, WSP(bf16, WS_XN), D, WSP(bf16, WS_W + W_OUT), Mffn, D, D, (L == 0) ? PF(I_X) : (const float*)POUT(), (L == 0) ? PF(I_CTX) : WSP(const float, WS_HCTX), POUT(), WSP(float, WS_HCTX), WSP(float, WS_MOD) + (size_t)L * 9 * 6144 + 2048);
        GRID_SYNC();
#ifdef DBG
        if constexpr (L == 0) { PHASE_IDS unsigned char* ws = PWS(); const unsigned sidx = (unsigned)gtid; const int row = hsh(sidx + 13u) % MT, col = hsh(sidx * 7u + 3u) % 1024; const bool isc = row >= ML; const int mi = isc ? 8 : (row >> 12);
            const bf16* xr = WSP(bf16, WS_XN) + (size_t)row * D; const float* w = PF(I_CWOUT) + col; float o = 0.f; for (int k = 0; k < 1024; ++k) o += h2f(xr + k) * w[(size_t)k * 1024];
            const float base = isc ? PF(I_CTX)[(size_t)(row - ML) * D + col] : PF(I_X)[(size_t)row * D + col]; const float got = isc ? WSP(float, WS_HCTX)[(size_t)(row - ML) * D + col] : POUT()[(size_t)row * D + col];
            if (dbg_bad(got, base + WSP(float, WS_MOD)[mi * 6144 + 2048 + col] * o)) dbg_flag(ws, 3); }
        GRID_SYNC();
#endif
        NORM_ROWS((const float*)POUT(), WSP(const float, WS_HCTX), PF(I_NFG) + L * D, 3072, 4096, Mffn);
        GRID_SYNC();
        GEMM_PHASE(6, pg8::EpiPair<1>, WSP(bf16, WS_XN), D, WSP(bf16, WS_W + W_GU), Mffn, 2 * FF, D, WSP(bf16, WS_BIG));
        GRID_SYNC();
#ifdef DBG
        if constexpr (L == 0) { PHASE_IDS unsigned char* ws = PWS(); const unsigned sidx = (unsigned)gtid; const int row = hsh(sidx + 17u) % MT, col = hsh(sidx * 11u + 4u) % FF;
            const bf16* xr = WSP(bf16, WS_XN) + (size_t)row * D; const float* wg = PF(I_FWG) + col; const float* wu = PF(I_FWU) + col; float g = 0.f, u = 0.f;
            for (int k = 0; k < 1024; ++k) { const float a = h2f(xr + k); g += a * wg[(size_t)k * FF]; u += a * wu[(size_t)k * FF]; }
            if (dbg_bad(h2f(WSP(bf16, WS_BIG) + (size_t)row * FF + col), silu_x(g) * u)) dbg_flag(ws, 4);
            const int row2 = hsh(sidx + 19u) % MT, col2 = hsh(sidx * 13u + 5u) % 1024; const bool isc = row2 >= ML;
            ((float*)(ws + DBG_SNAP))[sidx] = isc ? WSP(float, WS_HCTX)[(size_t)(row2 - ML) * D + col2] : POUT()[(size_t)row2 * D + col2]; }
        GRID_SYNC();
#endif
        GEMM_PHASE(7, pg8::EpiResid, WSP(bf16, WS_BIG), FF, WSP(bf16, WS_W + W_DN), Mffn, D, FF, (const float*)POUT(), WSP(const float, WS_HCTX), POUT(), WSP(float, WS_HCTX), WSP(float, WS_MOD) + (size_t)L * 9 * 6144 + 5120);
        if constexpr (L < 3) convert_weights<L + 1, 1, (Mffn == MT) ? 32 : 0>(lds, G, bx, vcu);
        if (L < 3) GRID_SYNC();
#ifdef DBG
        if constexpr (L == 0) { PHASE_IDS unsigned char* ws = PWS(); const unsigned sidx = (unsigned)gtid; const int row2 = hsh(sidx + 19u) % MT, col2 = hsh(sidx * 13u + 5u) % 1024; const bool isc = row2 >= ML; const int mi = isc ? 8 : (row2 >> 12);
            const bf16* hr = WSP(bf16, WS_BIG) + (size_t)row2 * FF; const float* w = PF(I_FWD) + col2; float o = 0.f; for (int k = 0; k < FF; ++k) o += h2f(hr + k) * w[(size_t)k * 1024];
            const float got = isc ? WSP(float, WS_HCTX)[(size_t)(row2 - ML) * D + col2] : POUT()[(size_t)row2 * D + col2];
            if (dbg_bad(got, ((float*)(ws + DBG_SNAP))[sidx] + WSP(float, WS_MOD)[mi * 6144 + 5120 + col2] * o)) dbg_flag(ws, 4); }
        GRID_SYNC();
#endif
    }
}

__global__ void __launch_bounds__(512, 2) fwd_mega(Args args) {
    extern __shared__ __attribute__((aligned(16))) unsigned char lds_raw[];
    cg::grid_group grid = cg::this_grid();
    LAS unsigned char* lds = (LAS unsigned char*)lds_raw;
    const int G = gridDim.x, bx = blockIdx.x;
    const int vcu = (G % 8 == 0) ? (bx % 8) * (G / 8) + bx / 8 : bx;
    const int NGW = G * 8, GS = G * 512;
    if (threadIdx.x < 2) ((volatile LAS unsigned*)(lds + BARGEN_OFF))[threadIdx.x] = 0u;
    __syncthreads();
    const XcdBarrier xbar = xcd_barrier_post((unsigned*)(PWS() + WS_BAR), (volatile LAS unsigned*)(lds + BARGEN_OFF));
    grid.sync();
    {
        PHASE_IDS
        unsigned char* ws = PWS();
        float* rowss = (float*)(ws + WS_ROWSS); float* tabM = (float*)(ws + WS_TAB); float* tabD = tabM + 1024; float* MOD = (float*)(ws + WS_MOD);
        const float* cvec = PF(I_C); const float* cctx = PF(I_CCTX); const float* mod_w = PF(I_MODW); const float* mod_b = PF(I_MODB);
        LAS float* sl = (LAS float*)lds; LAS float* red = sl + 9 * 1024;
        for (int i = tid; i < 9 * 1024; i += 512) { const int j = i >> 10, k = i & 1023; const float v = j < 8 ? cvec[j * 1024 + k] : cctx[k]; sl[i] = v / (1.0f + __expf(-v)); }
        __syncthreads();
        for (int item = bx; item < 4 * 96; item += G) {
            const int l = item / 96, n0 = (item % 96) * 64;
            const float* Wp = mod_w + (size_t)l * 1024 * 6144 + n0 + lane; const int k0 = wave * 128;
            float a0 = 0.f, a1 = 0.f, a2 = 0.f, a3 = 0.f, a4 = 0.f, a5 = 0.f, a6 = 0.f, a7 = 0.f, a8 = 0.f;
#pragma unroll 32
            for (int kk = 0; kk < 128; ++kk) { const float wv = Wp[(size_t)(k0 + kk) * 6144]; const LAS float* sp = sl + k0 + kk;
                a0 += sp[0] * wv; a1 += sp[1024] * wv; a2 += sp[2048] * wv; a3 += sp[3072] * wv; a4 += sp[4096] * wv; a5 += sp[5120] * wv; a6 += sp[6144] * wv; a7 += sp[7168] * wv; a8 += sp[8192] * wv; }
            LAS float* rp = red + wave * 9 * 64 + lane;
            rp[0] = a0; rp[64] = a1; rp[128] = a2; rp[192] = a3; rp[256] = a4; rp[320] = a5; rp[384] = a6; rp[448] = a7; rp[512] = a8;
            __syncthreads();
            for (int o = tid; o < 9 * 64; o += 512) { const int j = o >> 6, ln = o & 63; float s = mod_b[l * 6144 + n0 + ln];
#pragma unroll
                for (int w8 = 0; w8 < 8; ++w8) s += red[(w8 * 9 + j) * 64 + ln];
                MOD[(size_t)(l * 9 + j) * 6144 + n0 + ln] = s; }
            __syncthreads();
        }
        for (int i = gtid; i < 4 * MT; i += GS) rowss[i] = 0.f;
#ifdef DBG
        if (gtid < 64) ((unsigned*)(ws + DBG_OFF))[gtid] = 0u;
#endif
        if (bx == G - 1) {
            for (int i = tid; i < 512 + 1024; i += 512) {
                const bool dm = i >= 512; const int ii = dm ? i - 512 : i; const int nf = dm ? 16 : 8; const int pos = ii / nf, fi = ii % nf;
                const double base = dm ? 0.5623413251903491 : 0.31622776601683794;
                double f = 1.0; for (int q = 0; q < fi; ++q) f *= base;
                double a = (double)pos * f;
                const double twopi = 6.283185307179586476925; const double kq = __builtin_rint(a / twopi); a -= kq * twopi;
                double sn = a, cs = 1.0, term_s = a, term_c = 1.0; const double a2 = a * a;
                for (int q = 1; q < 16; ++q) { term_c *= -a2 / (double)((2 * q - 1) * (2 * q)); term_s *= -a2 / (double)((2 * q) * (2 * q + 1)); cs += term_c; sn += term_s; }
                float* tb = dm ? tabD : tabM; const int half = dm ? 1024 : 512;
                tb[pos * nf + fi] = (float)cs; tb[half + pos * nf + fi] = (float)sn;
            }
        }
    }
    convert_weights<0, 0>(lds, G, bx, vcu);
    GRID_SYNC();

    layer_fn<0>(lds, G, bx, vcu, xbar);
    layer_fn<1>(lds, G, bx, vcu, xbar);
    layer_fn<2>(lds, G, bx, vcu, xbar);
    layer_fn<3>(lds, G, bx, vcu, xbar);
#ifdef DBG
    GRID_SYNC();
    if (blockIdx.x == 0 && threadIdx.x == 0) { volatile unsigned* dw = (volatile unsigned*)(PWS() + DBG_OFF); unsigned m = 0; const unsigned nl = dw[4], fl = dw[5], nc = dw[6], fc = dw[7];
        m = 0; { m = (dw[16] ? 1u : 0u) + (dw[17] ? 2u : 0u) + (dw[18] ? 4u : 0u) + (dw[19] > 16u ? 8u : 0u); } (void)nc; (void)fc; (void)nl; (void)fl; POUT()[0] += 1000.0f * (float)m; }
#endif
}

extern "C" void kernel_launch(void* const* d_in, const int* in_sizes, int n_in, void* d_out, int out_size, void* d_ws, size_t ws_size, hipStream_t stream) {
    static int grid_blocks = 0;
    if (grid_blocks == 0) {
        if (n_in != 34 || ws_size < WS_END) { fprintf(stderr, "kernel_launch: unexpected n_in %d or ws_size %zu (< %zu)\n", n_in, ws_size, (size_t)WS_END); grid_blocks = -1; return; }
        int dev = 0, cus = 0, per_cu = 0;
        (void)hipGetDevice(&dev);
        (void)hipDeviceGetAttribute(&cus, hipDeviceAttributeMultiprocessorCount, dev);
        (void)hipFuncSetAttribute((const void*)fwd_mega, hipFuncAttributeMaxDynamicSharedMemorySize, LDS_BYTES);
        (void)hipOccupancyMaxActiveBlocksPerMultiprocessor(&per_cu, (const void*)fwd_mega, 512, LDS_BYTES);
        if (per_cu < 1) per_cu = 1;
        grid_blocks = cus * per_cu;
        fprintf(stderr, "grid %d (cus %d per_cu %d) ws_size %zu\n", grid_blocks, cus, per_cu, ws_size);
    }
    if (grid_blocks < 0) return;
    (void)hipMemsetAsync((char*)d_ws + WS_BAR, 0, XCD_BAR_WORDS * 4, stream);
    Args a{};
    for (int i = 0; i < 34; ++i) a.in[i] = (const float*)d_in[i];
    a.out = (float*)d_out; a.ws = (unsigned char*)d_ws;
    void* kargs[] = {&a};
    hipError_t e = hipLaunchCooperativeKernel((void*)fwd_mega, dim3(grid_blocks), dim3(512), kargs, LDS_BYTES, stream);
    if (e != hipSuccess) fprintf(stderr, "cooperative launch failed: %s (grid %d)\n", hipGetErrorString(e), grid_blocks);
}
```
